# Optimizing an MI355X kernel written in HIP

```python
import math
import jax
import jax.numpy as jnp
from jax import lax
import numpy as np

D_MODEL = 2048
BATCH = 4
SEQ = 2048
DEPTH = 4

GRID_W = 64
CTX_LEN = 256
HEAD_DIM = 128
Q_BLOCK = 128
ROPE_THETA = 10000.0
NORM_EPS = 1e-6
NEG_INF = -1e30

A_HEADS = 4
A_KV_HEADS = 2
A_GROUP = A_HEADS // A_KV_HEADS
B_HEADS = 4
B_KV_HEADS = 2
B_GROUP = B_HEADS // B_KV_HEADS
WINDOW = 128
C_HEADS = 4
C_QK_DIM = HEAD_DIM // 2
D_HEADS = 4
MLA_Q_RANK = 512
MLA_KV_RANK = 512
MLA_NOPE = 128
MLA_ROPE = 64
MLA_V = 128

N_BRANCH = 4
BRANCH_W = 4 * HEAD_DIM
_FFN_RAW = -(-8 * D_MODEL // 3)
FFN_HIDDEN = 256 * (-(-_FFN_RAW // 256))

ALPHA = (2 * DEPTH) ** 0.25
BETA = (8 * DEPTH) ** -0.25

IN_SIZES = (
    A_HEADS * HEAD_DIM, A_KV_HEADS * HEAD_DIM, A_KV_HEADS * HEAD_DIM,
    B_HEADS * HEAD_DIM, B_KV_HEADS * HEAD_DIM, B_KV_HEADS * HEAD_DIM,
    C_HEADS * 2 * C_QK_DIM, C_HEADS * 2 * C_QK_DIM, C_HEADS * HEAD_DIM,
    MLA_Q_RANK, MLA_KV_RANK, MLA_ROPE,
    N_BRANCH * D_MODEL,
)
D_IN = sum(IN_SIZES)

kernel_name = 'hybrid_parallel_mixer_dit_block'


def _standardise(x):
    xf = x.astype(jnp.float32)
    mu = jnp.mean(xf, axis=-1, keepdims=True)
    var = jnp.mean(jnp.square(xf - mu), axis=-1, keepdims=True)
    return (xf - mu) * lax.rsqrt(var + NORM_EPS)


def layer_norm(x, g, b):
    return (_standardise(x) * g.astype(jnp.float32) + b.astype(jnp.float32)).astype(x.dtype)


def rms_norm(x, g):
    xf = x.astype(jnp.float32)
    y = xf * lax.rsqrt(jnp.mean(xf * xf, axis=-1, keepdims=True) + NORM_EPS)
    return (y * g.astype(jnp.float32)).astype(x.dtype)


def axial_tables(pos_row, pos_col, rot_dim):
    axis_dim = rot_dim // 2
    freqs = ROPE_THETA ** (-jnp.arange(0, axis_dim, 2, dtype=jnp.float32) / axis_dim)
    ang_r = pos_row.astype(jnp.float32)[:, None] * freqs[None, :]
    ang_c = pos_col.astype(jnp.float32)[:, None] * freqs[None, :]
    return (jnp.cos(ang_r), jnp.sin(ang_r), jnp.cos(ang_c), jnp.sin(ang_c))


def _rot_half(x, cos, sin):
    h = x.shape[-1] // 2
    x1, x2 = x[..., :h], x[..., h:]
    return jnp.concatenate([x1 * cos - x2 * sin, x2 * cos + x1 * sin], axis=-1)


def axial_rope(x, tabs):
    cr, sr, cc, sc = tabs
    extra = (1,) * (x.ndim - 3)
    shp = lambda t: t.reshape((t.shape[0],) + extra + (t.shape[1],))
    h = x.shape[-1] // 2
    xf = x.astype(jnp.float32)
    out = jnp.concatenate([_rot_half(xf[..., :h], shp(cr), shp(sr)),
                           _rot_half(xf[..., h:], shp(cc), shp(sc))], axis=-1)
    return out.astype(x.dtype)


def softmax32(s):
    return jax.nn.softmax(s.astype(jnp.float32), axis=-1)


def block_sweep(fn, *qs):
    T = qs[0].shape[1]
    nb = T // Q_BLOCK
    blocks = tuple(jnp.moveaxis(q.reshape((q.shape[0], nb, Q_BLOCK) + q.shape[2:]), 1, 0) for q in qs)
    out = lax.map(lambda a: fn(*a), blocks)
    out = jnp.moveaxis(out, 0, 1)
    return out.reshape((out.shape[0], T) + out.shape[3:])


def gqa_core(q, k, v):
    s = jnp.einsum('bqhgd,bshd->bhgqs', q, k) * (q.shape[-1] ** -0.5)
    p = softmax32(s).astype(v.dtype)
    return jnp.einsum('bhgqs,bshd->bqhgd', p, v)


def sink_attention(q, k, v, sink):
    s = jnp.einsum('bqhgd,bshd->bhgqs', q, k) * (q.shape[-1] ** -0.5)
    sk = jnp.broadcast_to(sink.astype(jnp.float32).reshape(1, B_KV_HEADS, B_GROUP, 1, 1), s.shape[:-1] + (1,))
    p = softmax32(jnp.concatenate([s.astype(jnp.float32), sk], axis=-1))[..., :-1].astype(v.dtype)
    return jnp.einsum('bhgqs,bshd->bqhgd', p, v)


def band_mask(nb):
    r = jnp.arange(Q_BLOCK)[None, :, None]
    j = jnp.arange(3 * Q_BLOCK)[None, None, :]
    n = jnp.arange(nb)[:, None, None]
    qpos = n * Q_BLOCK + r
    kpos = n * Q_BLOCK - WINDOW + j
    return (jnp.abs(qpos - kpos) <= WINDOW) & (kpos >= 0) & (kpos < nb * Q_BLOCK)


def window_sink_attention(q, k_lat, v_lat, k_ctx, v_ctx, sink):
    B_, T_, KVH, G, d = q.shape
    nb = T_ // Q_BLOCK
    pad = ((0, 0), (WINDOW, WINDOW), (0, 0), (0, 0))
    kp = jnp.pad(k_lat, pad).reshape(B_, nb + 2, Q_BLOCK, KVH, d)
    vp = jnp.pad(v_lat, pad).reshape(B_, nb + 2, Q_BLOCK, KVH, d)
    kb = jnp.concatenate([kp[:, :-2], kp[:, 1:-1], kp[:, 2:]], axis=2)
    vb = jnp.concatenate([vp[:, :-2], vp[:, 1:-1], vp[:, 2:]], axis=2)
    qb = q.reshape(B_, nb, Q_BLOCK, KVH, G, d)
    scale = d ** -0.5
    s_band = jnp.einsum('bnqhgd,bnkhd->bhgnqk', qb, kb).astype(jnp.float32) * scale
    s_band = jnp.where(band_mask(nb), s_band, NEG_INF)
    s_ctx = jnp.einsum('bnqhgd,bchd->bhgnqc', qb, k_ctx).astype(jnp.float32) * scale
    sk = jnp.broadcast_to(sink.astype(jnp.float32).reshape(1, KVH, G, 1, 1, 1), s_band.shape[:-1] + (1,))
    p = softmax32(jnp.concatenate([s_band, s_ctx, sk], axis=-1))
    nk = 3 * Q_BLOCK
    p_band = p[..., :nk].astype(v_lat.dtype)
    p_ctx = p[..., nk:nk + k_ctx.shape[1]].astype(v_lat.dtype)
    o = jnp.einsum('bhgnqk,bnkhd->bnqhgd', p_band, vb) + jnp.einsum('bhgnqc,bchd->bnqhgd', p_ctx, v_ctx)
    return o.reshape(B_, T_, KVH, G, d)


def diff_core(q, k, v, lam):
    s = jnp.einsum('bqhcd,bshcd->bhcqs', q, k) * (q.shape[-1] ** -0.5)
    p = softmax32(s)
    w = (p[:, :, 0] - lam * p[:, :, 1]).astype(v.dtype)
    return jnp.einsum('bhqs,bshd->bqhd', w, v)


def diff_finish(o, g, lam_init):
    return rms_norm(o, g) * (1.0 - lam_init)


def mla_core(q_nope, q_rope, k_nope, k_rope, v):
    s = (jnp.einsum('bqhd,bshd->bhqs', q_nope, k_nope)
         + jnp.einsum('bqhd,bsd->bhqs', q_rope, k_rope)) * ((MLA_NOPE + MLA_ROPE) ** -0.5)
    p = softmax32(s).astype(v.dtype)
    return jnp.einsum('bhqs,bshd->bqhd', p, v)


def project_heads(h, w_in, a_qk_norm, mla_q_norm, mla_w_q_up, mla_kv_norm, mla_w_kv_up, tabs128, tabs64):
    B_, T_ = h.shape[0], h.shape[1]
    u = h @ w_in
    offs = np.cumsum(IN_SIZES)[:-1].tolist()
    aq, ak, av, bq, bk, bv, cq, ck, cv, dqa, dkva, dkr, gt = jnp.split(u, offs, axis=-1)
    rope128 = (lambda t: axial_rope(t, tabs128)) if tabs128 is not None else (lambda t: t)
    rope64 = (lambda t: axial_rope(t, tabs64)) if tabs64 is not None else (lambda t: t)
    dq = (rms_norm(dqa, mla_q_norm) @ mla_w_q_up).reshape(B_, T_, D_HEADS, MLA_NOPE + MLA_ROPE)
    dkv = (rms_norm(dkva, mla_kv_norm) @ mla_w_kv_up).reshape(B_, T_, D_HEADS, MLA_NOPE + MLA_V)
    return {
        'aq': rope128(rms_norm(aq.reshape(B_, T_, A_KV_HEADS, A_GROUP, HEAD_DIM), a_qk_norm[0])),
        'ak': rope128(rms_norm(ak.reshape(B_, T_, A_KV_HEADS, HEAD_DIM), a_qk_norm[1])),
        'av': av.reshape(B_, T_, A_KV_HEADS, HEAD_DIM),
        'bq': rope128(bq.reshape(B_, T_, B_KV_HEADS, B_GROUP, HEAD_DIM)),
        'bk': rope128(bk.reshape(B_, T_, B_KV_HEADS, HEAD_DIM)),
        'bv': bv.reshape(B_, T_, B_KV_HEADS, HEAD_DIM),
        'cq': rope64(cq.reshape(B_, T_, C_HEADS, 2, C_QK_DIM)),
        'ck': rope64(ck.reshape(B_, T_, C_HEADS, 2, C_QK_DIM)),
        'cv': cv.reshape(B_, T_, C_HEADS, HEAD_DIM),
        'dq_nope': dq[..., :MLA_NOPE],
        'dq_rope': rope64(dq[..., MLA_NOPE:]),
        'dk_nope': dkv[..., :MLA_NOPE],
        'dv': dkv[..., MLA_NOPE:],
        'dk_rope': rope64(dkr),
        'gates': jax.nn.sigmoid(gt).reshape(B_, T_, N_BRANCH, D_MODEL),
    }


def latent_mixers(L, C, sink, lam, c_subln, lam_init):
    B_, T_ = L['av'].shape[0], L['av'].shape[1]
    cat = lambda a, b: jnp.concatenate([a, b], axis=1)
    kA, vA = cat(C['ak'], L['ak']), cat(C['av'], L['av'])
    oA = block_sweep(lambda qb: gqa_core(qb, kA, vA), L['aq'])
    oB = window_sink_attention(L['bq'], L['bk'], L['bv'], C['bk'], C['bv'], sink)
    kC, vC = cat(C['ck'], L['ck']), cat(C['cv'], L['cv'])
    oC = diff_finish(block_sweep(lambda qb: diff_core(qb, kC, vC, lam), L['cq']), c_subln, lam_init)
    kDn, kDr, vD = cat(C['dk_nope'], L['dk_nope']), cat(C['dk_rope'], L['dk_rope']), cat(C['dv'], L['dv'])
    oD = block_sweep(lambda qn, qr: mla_core(qn, qr, kDn, kDr, vD), L['dq_nope'], L['dq_rope'])
    return [o.reshape(B_, T_, BRANCH_W) for o in (oA, oB, oC, oD)]


def context_mixers(C, sink, lam, c_subln, lam_init):
    B_, S_ = C['av'].shape[0], C['av'].shape[1]
    oA = gqa_core(C['aq'], C['ak'], C['av'])
    oB = sink_attention(C['bq'], C['bk'], C['bv'], sink)
    oC = diff_finish(diff_core(C['cq'], C['ck'], C['cv'], lam), c_subln, lam_init)
    oD = mla_core(C['dq_nope'], C['dq_rope'], C['dk_nope'], C['dk_rope'], C['dv'])
    return [o.reshape(B_, S_, BRANCH_W) for o in (oA, oB, oC, oD)]


def merge_branches(outs, gates, w_branch, w_out):
    y = gates[:, :, 0] * (outs[0] @ w_branch[0])
    for m in range(1, N_BRANCH):
        y = y + gates[:, :, m] * (outs[m] @ w_branch[m])
    return y @ w_out


def swiglu(h, w_in, w_out):
    g, u = jnp.split(h @ w_in, 2, axis=-1)
    return (jax.nn.silu(g) * u) @ w_out


def setup_inputs(seed: int = 0) -> dict:
    key = jax.random.key(seed)
    ks = jax.random.split(key, 24)
    nrm = lambda k, shape, s: jax.random.normal(k, shape, jnp.float32) * s
    L, D = DEPTH, D_MODEL
    return {
        'x': nrm(ks[0], (BATCH, SEQ, D), 1.0),
        'c': nrm(ks[1], (BATCH, D), 1.0),
        'ctx': nrm(ks[2], (BATCH, CTX_LEN, D), 1.0),
        'c_ctx': nrm(ks[3], (D,), 1.0),
        'w_ada': nrm(ks[4], (L, D, 6 * D), 0.5 * D ** -0.5),
        'b_ada': nrm(ks[5], (L, 6 * D), 0.02),
        'w_in': nrm(ks[6], (L, D, D_IN), D ** -0.5),
        'a_qk_norm': 1.0 + nrm(ks[7], (L, 2, HEAD_DIM), 0.02),
        'b_sink': nrm(ks[8], (L, B_HEADS), 0.5),
        'c_lambda': nrm(ks[9], (L, 4, C_QK_DIM), 0.1),
        'c_subln': 1.0 + nrm(ks[10], (L, HEAD_DIM), 0.02),
        'mla_q_norm': 1.0 + nrm(ks[11], (L, MLA_Q_RANK), 0.02),
        'mla_w_q_up': nrm(ks[12], (L, MLA_Q_RANK, D_HEADS * (MLA_NOPE + MLA_ROPE)), MLA_Q_RANK ** -0.5),
        'mla_kv_norm': 1.0 + nrm(ks[13], (L, MLA_KV_RANK), 0.02),
        'mla_w_kv_up': nrm(ks[14], (L, MLA_KV_RANK, D_HEADS * (MLA_NOPE + MLA_V)), MLA_KV_RANK ** -0.5),
        'w_branch': nrm(ks[15], (L, N_BRANCH, BRANCH_W, D), BRANCH_W ** -0.5),
        'w_out': nrm(ks[16], (L, D, D), BETA * D ** -0.5),
        'ln_mix_g': 1.0 + nrm(ks[17], (L, D), 0.02),
        'ln_mix_b': nrm(ks[18], (L, D), 0.02),
        'w_ffn_in': nrm(ks[19], (L, D, 2 * FFN_HIDDEN), D ** -0.5),
        'w_ffn_out': nrm(ks[20], (L, FFN_HIDDEN, D), BETA * FFN_HIDDEN ** -0.5),
        'ln_ffn_g': 1.0 + nrm(ks[21], (L, D), 0.02),
        'ln_ffn_b': nrm(ks[22], (L, D), 0.02),
    }


def reference(x, c, ctx, c_ctx, w_ada, b_ada, w_in, a_qk_norm, b_sink, c_lambda, c_subln,
              mla_q_norm, mla_w_q_up, mla_kv_norm, mla_w_kv_up, w_branch, w_out,
              ln_mix_g, ln_mix_b, w_ffn_in, w_ffn_out, ln_ffn_g, ln_ffn_b):
    T = x.shape[1]
    ROWS = T // GRID_W
    pos_row = jnp.repeat(jnp.arange(ROWS, dtype=jnp.int32), GRID_W)
    pos_col = jnp.tile(jnp.arange(GRID_W, dtype=jnp.int32), ROWS)
    tabs128 = axial_tables(pos_row, pos_col, HEAD_DIM)
    tabs64 = axial_tables(pos_row, pos_col, C_QK_DIM)

    x = _standardise(x).astype(x.dtype)
    xc = _standardise(ctx).astype(ctx.dtype)
    silu_c = jax.nn.silu(c)
    silu_cc = jax.nn.silu(c_ctx)

    for l in range(DEPTH):
        last = l == DEPTH - 1
        ada = silu_c @ w_ada[l] + b_ada[l]
        ada_c = silu_cc @ w_ada[l] + b_ada[l]
        sh_a, sc_a, g_a, sh_f, sc_f, g_f = jnp.split(ada[:, None, :], 6, axis=-1)
        csh_a, csc_a, cg_a, csh_f, csc_f, cg_f = jnp.split(ada_c, 6, axis=-1)
        lam_init = 0.8 - 0.6 * math.exp(-0.3 * l)
        lq1, lk1, lq2, lk2 = (c_lambda[l, i].astype(jnp.float32) for i in range(4))
        lam = jnp.exp(jnp.sum(lq1 * lk1)) - jnp.exp(jnp.sum(lq2 * lk2)) + lam_init

        proj = lambda h, t128, t64: project_heads(h, w_in[l], a_qk_norm[l], mla_q_norm[l], mla_w_q_up[l],
                                                  mla_kv_norm[l], mla_w_kv_up[l], t128, t64)
        Lh = proj(x * (1.0 + sc_a) + sh_a, tabs128, tabs64)
        Ch = proj(xc * (1.0 + csc_a) + csh_a, None, None)

        outs = latent_mixers(Lh, Ch, b_sink[l], lam, c_subln[l], lam_init)
        mix = merge_branches(outs, Lh['gates'], w_branch[l], w_out[l])
        x = layer_norm(ALPHA * x + g_a * mix, ln_mix_g[l], ln_mix_b[l])
        ffn = swiglu(x * (1.0 + sc_f) + sh_f, w_ffn_in[l], w_ffn_out[l])
        x = layer_norm(ALPHA * x + g_f * ffn, ln_ffn_g[l], ln_ffn_b[l])

        if not last:
            couts = context_mixers(Ch, b_sink[l], lam, c_subln[l], lam_init)
            cmix = merge_branches(couts, Ch['gates'], w_branch[l], w_out[l])
            xc = layer_norm(ALPHA * xc + cg_a * cmix, ln_mix_g[l], ln_mix_b[l])
            cffn = swiglu(xc * (1.0 + csc_f) + csh_f, w_ffn_in[l], w_ffn_out[l])
            xc = layer_norm(ALPHA * xc + cg_f * cffn, ln_ffn_g[l], ln_ffn_b[l])
    return x
```

```cpp
#include <hip/hip_runtime.h>
#include <cstdio>
#include <cstdint>

#ifndef MK_N_LAUNCHES
#define MK_N_LAUNCHES 1
#endif

#define LAS __attribute__((address_space(3)))
#define GAS __attribute__((address_space(1)))
typedef unsigned short bf16_t;
typedef short bf16x8 __attribute__((ext_vector_type(8)));
typedef short s16x4 __attribute__((ext_vector_type(4)));
typedef float f32x2 __attribute__((ext_vector_type(2)));
typedef float f32x4 __attribute__((ext_vector_type(4)));
typedef float f32x16 __attribute__((ext_vector_type(16)));
typedef unsigned u32x2 __attribute__((ext_vector_type(2)));
typedef unsigned u32x4 __attribute__((ext_vector_type(4)));

constexpr int DM = 2048, NBATCH = 4, SEQ = 2048, DEPTH = 4, CTXL = 256;
constexpr int ML = NBATCH * SEQ, MC = NBATCH * CTXL, MT = ML + MC;
constexpr int NIN_SRC = 12864, NIN = 13056;
constexpr int FF = 5632;
constexpr float NORM_EPS = 1e-6f;
constexpr float ALPHA = 1.681792830507429f;
constexpr int LDACT = 5632;
constexpr int C_AQ = 0, C_AK = 512, C_AV = 768, C_BQ = 1024, C_BK = 1536, C_BV = 1792, C_CQ = 2048, C_CK = 2560, C_CV = 3072, C_DQ = 3584, C_DK = 4352, C_DV = 5120;

constexpr size_t MiB = 1u << 20;
constexpr size_t WS_CTL = 0, CTL_ZERO_BYTES = 1 * MiB;
constexpr size_t WS_ADA = 1 * MiB;
constexpr size_t WS_T128 = 2 * MiB;
constexpr size_t WS_T64 = 3 * MiB;
constexpr size_t WS_LAM = 3 * MiB + 512 * 1024;
constexpr size_t WS_SSQ = 4 * MiB;
constexpr size_t WS_X = 8 * MiB;
constexpr size_t SZ_F32ROWS = (size_t)MT * DM * 4;
constexpr size_t WS_PRE = WS_X + SZ_F32ROWS;
constexpr size_t WS_HB = WS_PRE + SZ_F32ROWS;
constexpr size_t SZ_BF16ROWS = (size_t)MT * DM * 2;
constexpr size_t WS_ACT = WS_HB + SZ_BF16ROWS;
constexpr size_t WS_DQKV = WS_ACT + (size_t)MT * LDACT * 2;
constexpr size_t WS_G = WS_DQKV + (size_t)2 * MT * 512 * 2;
constexpr size_t WS_OUTS = WS_G + (size_t)MT * 8192 * 2;
constexpr size_t WS_Y = WS_OUTS + SZ_BF16ROWS;
constexpr size_t WS_FH = WS_Y + SZ_BF16ROWS;
constexpr size_t WS_O1 = WS_FH + (size_t)MT * FF * 2;
constexpr size_t WS_W = WS_O1 + (size_t)MT * 512 * 4;
constexpr size_t WL_IN = 0, WL_UP = WL_IN + (size_t)NIN * DM * 2, WL_BR = WL_UP + (size_t)1792 * 512 * 2, WL_OUT = WL_BR + (size_t)8192 * 512 * 2,
                 WL_FI = WL_OUT + (size_t)DM * DM * 2, WL_FO = WL_FI + (size_t)2 * FF * DM * 2, WL_SIZE = WL_FO + (size_t)DM * FF * 2;
constexpr size_t WS_END = WS_W + DEPTH * WL_SIZE;
static_assert(WS_SSQ + (size_t)MT * 16 * 4 <= WS_X && WS_ADA + (size_t)DEPTH * 5 * 6 * DM * 4 <= WS_T128, "ws map");
constexpr int CW_BAR = 4096;
constexpr int CW_QUEUE = 16384;

constexpr int RING_BYTES = 131072, LDSCTL_OFF = RING_BYTES, XCH_OFF = LDSCTL_OFF + 1024, LDS_BYTES = 147456;
static_assert(XCH_OFF + 8192 <= LDS_BYTES, "LDS map");

typedef __bf16 bf16x2_t __attribute__((ext_vector_type(2)));
__device__ __forceinline__ unsigned cvt_pk_bf16(float lo, float hi) { bf16x2_t v = {(__bf16)lo, (__bf16)hi}; return __builtin_bit_cast(unsigned, v); }
__device__ __forceinline__ float bf_lo(unsigned w) { return __uint_as_float(w << 16); }
__device__ __forceinline__ float bf_hi(unsigned w) { return __uint_as_float(w & 0xffff0000u); }
__device__ __forceinline__ float fast_sigmoid(float x) { return __builtin_amdgcn_rcpf(1.0f + __builtin_amdgcn_exp2f(-1.4426950408889634f * x)); }
__device__ __forceinline__ float wave_sum(float v) {
#pragma unroll
    for (int o = 1; o < 64; o <<= 1) v += __shfl_xor(v, o);
    return v;
}
__host__ __device__ __forceinline__ int L128(int p) { const int i = p >> 1, odd = p & 1; return i + 32 * odd + (i >= 32 ? 32 : 0); }
__host__ __device__ __forceinline__ int L64(int p) { const int i = p >> 1, odd = p & 1; return i + 16 * odd + (i >= 16 ? 16 : 0); }
__host__ __device__ __forceinline__ int win_src(int c) {
    const int t = c >> 8, w = c & 255;
    if (t >= 19) return 4672 + (c - 19 * 256);
    switch (t) {
        case 0: case 1: { const int cc = c; return 0 + (cc >> 7) * 128 + L128(cc & 127); }
        case 2: return 512 + (w >> 7) * 128 + L128(w & 127);
        case 3: return 768 + w;
        case 4: case 5: { const int cc = c - 1024; return 1024 + (cc >> 7) * 128 + L128(cc & 127); }
        case 6: return 1536 + (w >> 7) * 128 + L128(w & 127);
        case 7: return 1792 + w;
        case 8: case 9: { const int cc = c - 2048; return 2048 + (cc >> 6) * 64 + L64(cc & 63); }
        case 10: case 11: { const int cc = c - 2560; return 2560 + (cc >> 6) * 64 + L64(cc & 63); }
        case 12: case 13: return 3072 + (c - 3072);
        case 14: case 15: return 3584 + (c - 3584);
        case 16: case 17: return 4096 + (c - 4096);
        default: return 4608 + L64(w & 63);
    }
}

namespace pg8 {
constexpr int BM = 256, BK = 64, HALF = 128, HTB = HALF * BK * 2, STAGE_BYTES = 8 * HTB, NXCD = 8, WGM = 8;
__host__ __device__ __forceinline__ int lds_byte(int r, int c) { const int st = (r >> 4) * 2 + (c >> 5), rr = r & 15, cc = c & 31, ob = rr * 64 + cc * 2; return st * 1024 + (ob ^ (((ob >> 9) & 1) << 5)); }
__host__ __device__ __forceinline__ void stage_rc(int b, int& R, int& C) { const int st = b / 1024, sb = b % 1024, swz = sb ^ (((sb >> 9) & 1) << 5); R = (st >> 1) * 16 + swz / 64; C = (st & 1) * 32 + (swz % 64) / 2; }
__host__ __device__ __forceinline__ int perm32(int rho) { const int n = rho >> 4, i = rho & 15; return 8 * (i >> 2) + 4 * n + (i & 3); }
struct Unit { int pm, pn; };
struct Gemm { const bf16_t* A; const bf16_t* Bt; int K, lda, ldb; };
template <int AMODE  > struct Order {
    int nM, nN, nwg, G, c; int lda, ldb;
    __device__ void init(int nM_, int nN_, int G_, int c_, int lda_, int ldb_) { nM = nM_; nN = nN_; nwg = nM * nN; G = G_; c = c_; lda = lda_; ldb = ldb_; }
    __device__ bool next(int i, Unit& u) const {
        const long L = (long)i * G + c; if (L >= nwg) return false;
        int wgid = (int)L; { const int q = nwg / NXCD, r = nwg % NXCD, xcd = wgid % NXCD, off = wgid / NXCD; wgid = (xcd < r ? xcd * (q + 1) : r * (q + 1) + (xcd - r) * q) + off; }
        const int nig = WGM * nN, gid = wgid / nig, fm = gid * WGM, gsz = (nM - fm) < WGM ? (nM - fm) : WGM;
        u.pm = fm + ((wgid % nig) % gsz); u.pn = (wgid % nig) / gsz; return true;
    }
    __device__ __forceinline__ size_t a_off(const Unit& u) const {
        size_t o = (size_t)u.pm * BM * lda;
        if (AMODE == 1) o += (size_t)(u.pn >> 3) * 512;
        if (AMODE == 2) o += (u.pn >= 3) ? (size_t)MT * 512 : 0;
        return o;
    }
    __device__ __forceinline__ size_t b_off(const Unit& u) const { return (size_t)u.pn * BM * ldb; }
};

template <class Epi, class Sched>
__device__ __forceinline__ void gemm_phase(LAS unsigned char* lds, const Gemm g, const Sched& S, const Epi& E) {
    int tid_ = threadIdx.x; asm volatile("" : "+v"(tid_));
    const int tid = tid_, wid = __builtin_amdgcn_readfirstlane(tid >> 6), lane = tid & 63, wr = wid >> 2, wc = wid & 3, fr = lane & 15, fq = lane >> 4;
    const int K = g.K, nt = K / BK;
    unsigned voffA[2], voffB[2];
#pragma unroll
    for (int i = 0; i < 2; ++i) { int R, C; stage_rc(tid * 16 + i * 8192, R, C); const int Rb = Epi::PERM ? ((R & ~31) + perm32(R & 31)) : R;
        voffA[i] = (unsigned)(R * g.lda + C) * 2u; voffB[i] = (unsigned)(Rb * g.ldb + C) * 2u; }
    const size_t kstep = (size_t)(BK * 2);
    const size_t hstepA = (size_t)HALF * g.lda * 2, hstepB = (size_t)HALF * g.ldb * 2;
    const unsigned ldsw = (unsigned)wid * 1024u;
    const int aoff = lds_byte(wr * 64 + fr, fq * 8), boff = lds_byte(wc * 32 + fr, fq * 8);
#define PG8_SA(b, h) (((b) * 2 + (h)) * HTB)
#define PG8_SB(b, h) ((4 + (b) * 2 + (h)) * HTB)
#define PG8_STAGE(bufoff, gbase, voff) do { _Pragma("unroll") for (int _i = 0; _i < 2; ++_i) \
        __builtin_amdgcn_global_load_lds((const unsigned*)((const char*)(gbase) + (voff)[_i]), (LAS unsigned*)(lds + (bufoff) + ldsw + _i * 8192), 16, 0, 0); } while (0)
#define PG8_LDA(dst, b, h) do { _Pragma("unroll") for (int m = 0; m < 4; ++m) _Pragma("unroll") for (int k = 0; k < 2; ++k) dst[m][k] = *(const LAS bf16x8*)(lds + PG8_SA(b, h) + aoff + m * 2048 + k * 1024); } while (0)
#define PG8_LDB(dst, b, h) do { _Pragma("unroll") for (int n = 0; n < 2; ++n) _Pragma("unroll") for (int k = 0; k < 2; ++k) dst[n][k] = *(const LAS bf16x8*)(lds + PG8_SB(b, h) + boff + n * 2048 + k * 1024); } while (0)
#define PG8_MMA(ai, bj, At, Bt) do { __builtin_amdgcn_s_setprio(1); _Pragma("unroll") for (int m = 0; m < 4; ++m) _Pragma("unroll") for (int n = 0; n < 2; ++n) _Pragma("unroll") for (int k = 0; k < 2; ++k) \
        acc[ai][bj][m][n] = __builtin_amdgcn_mfma_f32_16x16x32_bf16(Bt[n][k], At[m][k], acc[ai][bj][m][n], 0, 0, 0); __builtin_amdgcn_s_setprio(0); } while (0)
#define PG8_WAIT_V(n) asm volatile("s_waitcnt vmcnt(" #n ")" ::: "memory")
#define PG8_WAIT_L(n) asm volatile("s_waitcnt lgkmcnt(" #n ")" ::: "memory")
#define PG8_BAR __builtin_amdgcn_s_barrier()
#define PG8_SCHED __builtin_amdgcn_sched_barrier(0)
    Unit cur, nxt; int ui = 0;
    if (!S.next(0, cur)) return;
    f32x4 acc[2][2][4][2];
#pragma unroll
    for (int a = 0; a < 2; ++a)
#pragma unroll
        for (int b = 0; b < 2; ++b)
#pragma unroll
            for (int m = 0; m < 4; ++m)
#pragma unroll
                for (int n = 0; n < 2; ++n) acc[a][b][m][n] = (f32x4){0.f, 0.f, 0.f, 0.f};
    bf16x8 At[4][2], B0[2][2], B1[2][2];
    const char* cA = (const char*)g.A + S.a_off(cur) * 2; const char* cB = (const char*)g.Bt + S.b_off(cur) * 2;
    PG8_STAGE(PG8_SB(0, 0), cB, voffB); PG8_STAGE(PG8_SB(0, 1), cB + hstepB, voffB); PG8_STAGE(PG8_SA(0, 0), cA, voffA); PG8_STAGE(PG8_SA(0, 1), cA + hstepA, voffA);
    if (wr == 1) PG8_BAR;
    PG8_WAIT_V(2); PG8_BAR;
    PG8_STAGE(PG8_SB(1, 0), cB + kstep, voffB); PG8_STAGE(PG8_SA(1, 0), cA + kstep, voffA); PG8_STAGE(PG8_SB(1, 1), cB + hstepB + kstep, voffB);
    PG8_WAIT_V(6); PG8_BAR;
    for (;;) {
        const bool has_next = S.next(ui + 1, nxt);
        const char* nA = has_next ? (const char*)g.A + S.a_off(nxt) * 2 : cA; const char* nB = has_next ? (const char*)g.Bt + S.b_off(nxt) * 2 : cB;
        for (int t = 0; t < nt; t += 2) {
            const bool last = (t == nt - 2);
            const char* a1 = cA + (size_t)(t + 1) * kstep;
            const char* a2 = last ? nA : cA + (size_t)(t + 2) * kstep; const char* b2 = last ? nB : cB + (size_t)(t + 2) * kstep;
            const char* a3 = a2 + kstep; const char* b3 = b2 + kstep;
            PG8_LDB(B0, 0, 0); PG8_LDB(B1, 0, 1); PG8_SCHED; PG8_LDA(At, 0, 0); PG8_STAGE(PG8_SA(1, 1), a1 + hstepA, voffA);
            PG8_WAIT_V(8); PG8_WAIT_L(0); PG8_BAR; PG8_MMA(0, 0, At, B0); PG8_MMA(0, 1, At, B1); PG8_BAR; PG8_SCHED;
            PG8_LDA(At, 0, 1); PG8_STAGE(PG8_SB(0, 0), b2, voffB); PG8_STAGE(PG8_SB(0, 1), b2 + hstepB, voffB); PG8_STAGE(PG8_SA(0, 0), a2, voffA);
            PG8_WAIT_V(8); PG8_WAIT_L(0); PG8_BAR; PG8_MMA(1, 0, At, B0); PG8_MMA(1, 1, At, B1); PG8_BAR; PG8_SCHED;
            PG8_LDB(B0, 1, 0); PG8_LDB(B1, 1, 1); PG8_SCHED; PG8_LDA(At, 1, 0); PG8_STAGE(PG8_SA(0, 1), a2 + hstepA, voffA);
            PG8_WAIT_V(8); PG8_WAIT_L(0); PG8_BAR; PG8_MMA(0, 0, At, B0); PG8_MMA(0, 1, At, B1); PG8_BAR; PG8_SCHED;
            PG8_LDA(At, 1, 1); PG8_STAGE(PG8_SB(1, 0), b3, voffB); PG8_STAGE(PG8_SB(1, 1), b3 + hstepB, voffB); PG8_STAGE(PG8_SA(1, 0), a3, voffA);
            PG8_WAIT_V(8); PG8_WAIT_L(0); PG8_BAR; PG8_MMA(1, 0, At, B0); PG8_MMA(1, 1, At, B1); PG8_BAR; PG8_SCHED;
        }
        if (wr == 0) PG8_BAR;
        E(acc, cur, wr, wc, fr, fq);
        if (!has_next) break;
#pragma unroll
        for (int a = 0; a < 2; ++a)
#pragma unroll
            for (int b = 0; b < 2; ++b)
#pragma unroll
                for (int m = 0; m < 4; ++m)
#pragma unroll
                    for (int n = 0; n < 2; ++n) acc[a][b][m][n] = (f32x4){0.f, 0.f, 0.f, 0.f};
        cur = nxt; cA = nA; cB = nB; ++ui;
        if (wr == 1) PG8_BAR;
    }
    PG8_WAIT_V(0);
    PG8_BAR;
#undef PG8_SA
#undef PG8_SB
#undef PG8_STAGE
#undef PG8_LDA
#undef PG8_LDB
#undef PG8_MMA
#undef PG8_WAIT_V
#undef PG8_WAIT_L
#undef PG8_BAR
#undef PG8_SCHED
}

struct EpiIn {
    static constexpr bool PERM = true;
    bf16_t* act; bf16_t* gates; bf16_t* dqkv; float* ssq; const f32x4* t128; const f32x4* t64; const float* qkn; LAS float* xch;
    __device__ __forceinline__ void operator()(const f32x4 (&acc)[2][2][4][2], const Unit& u, int wr, int wc, int fr, int fq) const {
        const int pn = u.pn, row0 = u.pm * BM + wr * 64 + fr, tc0 = wc * 32 + 8 * fq;
        if (pn >= 19) {
#pragma unroll
            for (int ai = 0; ai < 2; ++ai)
#pragma unroll
                for (int m = 0; m < 4; ++m) { bf16_t* rowp = gates + (size_t)(row0 + ai * HALF + m * 16) * 8192 + (pn - 19) * 256 + tc0;
#pragma unroll
                    for (int bj = 0; bj < 2; ++bj) { const f32x4 v0 = acc[ai][bj][m][0], v1 = acc[ai][bj][m][1]; u32x4 w;
                        w.x = cvt_pk_bf16(fast_sigmoid(v0[0]), fast_sigmoid(v0[1])); w.y = cvt_pk_bf16(fast_sigmoid(v0[2]), fast_sigmoid(v0[3]));
                        w.z = cvt_pk_bf16(fast_sigmoid(v1[0]), fast_sigmoid(v1[1])); w.w = cvt_pk_bf16(fast_sigmoid(v1[2]), fast_sigmoid(v1[3]));
                        *(u32x4*)(rowp + bj * HALF) = w; } }
            return;
        }
        const bool plain = (pn == 3) | (pn == 7) | (pn == 12) | (pn == 13) | (pn >= 14 && pn <= 17);
        if (plain) {
            bf16_t* base; int ld;
            if (pn >= 14) { base = dqkv + (pn >= 16 ? (size_t)MT * 512 : 0) + (pn & 1) * 256 + tc0; ld = 512; } else { base = act + pn * 256 + tc0; ld = LDACT; }
#pragma unroll
            for (int ai = 0; ai < 2; ++ai)
#pragma unroll
                for (int m = 0; m < 4; ++m) { const int row = row0 + ai * HALF + m * 16; bf16_t* rowp = base + (size_t)row * ld; float ss = 0.f;
#pragma unroll
                    for (int bj = 0; bj < 2; ++bj) { const f32x4 v0 = acc[ai][bj][m][0], v1 = acc[ai][bj][m][1]; u32x4 w;
                        ss += (v0[0] * v0[0] + v0[1] * v0[1]) + (v0[2] * v0[2] + v0[3] * v0[3]) + (v1[0] * v1[0] + v1[1] * v1[1]) + (v1[2] * v1[2] + v1[3] * v1[3]);
                        w.x = cvt_pk_bf16(v0[0], v0[1]); w.y = cvt_pk_bf16(v0[2], v0[3]); w.z = cvt_pk_bf16(v1[0], v1[1]); w.w = cvt_pk_bf16(v1[2], v1[3]);
                        *(u32x4*)(rowp + bj * HALF) = w; }
                    if (pn >= 14) { ss += __shfl_xor(ss, 16); ss += __shfl_xor(ss, 32); if (fq == 0) ssq[(size_t)row * 16 + (pn - 14) * 4 + wc] = ss; } }
            return;
        }
        const bool r128 = pn < 8, rms = pn < 3, lat = u.pm < 32;
        float gn[2][4];
        if (rms) { const float* gq = qkn + (pn == 2 ? 128 : 0);
#pragma unroll
            for (int n = 0; n < 2; ++n)
#pragma unroll
                for (int j = 0; j < 4; ++j) gn[n][j] = gq[L128(tc0 + 4 * n + j)];
#pragma unroll
            for (int ai = 0; ai < 2; ++ai)
#pragma unroll
                for (int m = 0; m < 4; ++m)
#pragma unroll
                    for (int bj = 0; bj < 2; ++bj) { const f32x4 v0 = acc[ai][bj][m][0], v1 = acc[ai][bj][m][1];
                        float ss = (v0[0] * v0[0] + v0[1] * v0[1]) + (v0[2] * v0[2] + v0[3] * v0[3]) + (v1[0] * v1[0] + v1[1] * v1[1]) + (v1[2] * v1[2] + v1[3] * v1[3]);
                        ss += __shfl_xor(ss, 16); ss += __shfl_xor(ss, 32);
                        if (fq == 0) xch[((ai * HALF + wr * 64 + m * 16 + fr) * 2 + bj) * 4 + wc] = ss; }
            asm volatile("s_waitcnt lgkmcnt(0)" ::: "memory"); __builtin_amdgcn_s_barrier(); asm volatile("" ::: "memory");
        }
        const int i0 = r128 ? (wc * 16 + 4 * fq) : ((wc & 1) * 16 + 4 * fq);
#pragma unroll
        for (int ai = 0; ai < 2; ++ai)
#pragma unroll
            for (int m = 0; m < 4; ++m) { const int row = row0 + ai * HALF + m * 16, t = row & (SEQ - 1);
                f32x4 cs0 = (f32x4){1.f, 0.f, 1.f, 0.f}, cs1 = cs0;
                if (lat) { const f32x4* tp = r128 ? (t128 + ((size_t)t * 64 + i0) / 2) : (t64 + ((size_t)t * 32 + i0) / 2); cs0 = tp[0]; cs1 = tp[1]; }
#pragma unroll
                for (int bj = 0; bj < 2; ++bj) { f32x4 v0 = acc[ai][bj][m][0], v1 = acc[ai][bj][m][1];
                    if (rms) { const f32x4 p = *(const LAS f32x4*)(xch + ((ai * HALF + wr * 64 + m * 16 + fr) * 2 + bj) * 4);
                        const float rs = __builtin_amdgcn_rsqf(((p[0] + p[1]) + (p[2] + p[3])) * (1.0f / 128.0f) + NORM_EPS);
                        v0[0] *= rs * gn[0][0]; v0[1] *= rs * gn[0][1]; v0[2] *= rs * gn[0][2]; v0[3] *= rs * gn[0][3];
                        v1[0] *= rs * gn[1][0]; v1[1] *= rs * gn[1][1]; v1[2] *= rs * gn[1][2]; v1[3] *= rs * gn[1][3]; }
                    const float a0 = v0[0] * cs0[0] - v0[1] * cs0[1], b0 = v0[1] * cs0[0] + v0[0] * cs0[1];
                    const float a1 = v0[2] * cs0[2] - v0[3] * cs0[3], b1 = v0[3] * cs0[2] + v0[2] * cs0[3];
                    const float a2 = v1[0] * cs1[0] - v1[1] * cs1[1], b2 = v1[1] * cs1[0] + v1[0] * cs1[1];
                    const float a3 = v1[2] * cs1[2] - v1[3] * cs1[3], b3 = v1[3] * cs1[2] + v1[2] * cs1[3];
                    u32x4 w; w.x = cvt_pk_bf16(a0, b0); w.y = cvt_pk_bf16(a1, b1); w.z = cvt_pk_bf16(a2, b2); w.w = cvt_pk_bf16(a3, b3);
                    bf16_t* dst;
                    if (pn == 18) { const int c = bj * HALF + tc0; dst = act + (size_t)row * LDACT + C_DK + (c >> 6) * 192 + 128 + (c & 63); }
                    else dst = act + (size_t)row * LDACT + pn * 256 + bj * HALF + tc0;
                    *(u32x4*)dst = w; } }
    }
};
struct EpiUp {
    static constexpr bool PERM = true;
    bf16_t* act; const float* ssq; const f32x4* t64;
    __device__ __forceinline__ void operator()(const f32x4 (&acc)[2][2][4][2], const Unit& u, int wr, int wc, int fr, int fq) const {
        const int pn = u.pn, row0 = u.pm * BM + wr * 64 + fr, tc0 = wc * 32 + 8 * fq; const bool lat = u.pm < 32;
        const int i0 = (wc & 1) * 16 + 4 * fq;
#pragma unroll
        for (int ai = 0; ai < 2; ++ai)
#pragma unroll
            for (int m = 0; m < 4; ++m) { const int row = row0 + ai * HALF + m * 16, t = row & (SEQ - 1);
                const f32x4* sp = (const f32x4*)(ssq + (size_t)row * 16 + (pn >= 3 ? 8 : 0)); const f32x4 s0 = sp[0], s1 = sp[1];
                const float rs = __builtin_amdgcn_rsqf((((s0[0] + s0[1]) + (s0[2] + s0[3])) + ((s1[0] + s1[1]) + (s1[2] + s1[3]))) * (1.0f / 512.0f) + NORM_EPS);
                f32x4 cs0 = (f32x4){1.f, 0.f, 1.f, 0.f}, cs1 = cs0;
                if (pn == 2 && lat) { const f32x4* tp = t64 + ((size_t)t * 32 + i0) / 2; cs0 = tp[0]; cs1 = tp[1]; }
#pragma unroll
                for (int bj = 0; bj < 2; ++bj) { f32x4 v0 = acc[ai][bj][m][0] * rs, v1 = acc[ai][bj][m][1] * rs; u32x4 w;
                    if (pn == 2) {
                        const float a0 = v0[0] * cs0[0] - v0[1] * cs0[1], b0 = v0[1] * cs0[0] + v0[0] * cs0[1];
                        const float a1 = v0[2] * cs0[2] - v0[3] * cs0[3], b1 = v0[3] * cs0[2] + v0[2] * cs0[3];
                        const float a2 = v1[0] * cs1[0] - v1[1] * cs1[1], b2 = v1[1] * cs1[0] + v1[0] * cs1[1];
                        const float a3 = v1[2] * cs1[2] - v1[3] * cs1[3], b3 = v1[3] * cs1[2] + v1[2] * cs1[3];
                        w.x = cvt_pk_bf16(a0, b0); w.y = cvt_pk_bf16(a1, b1); w.z = cvt_pk_bf16(a2, b2); w.w = cvt_pk_bf16(a3, b3);
                    } else { w.x = cvt_pk_bf16(v0[0], v0[1]); w.y = cvt_pk_bf16(v0[2], v0[3]); w.z = cvt_pk_bf16(v1[0], v1[1]); w.w = cvt_pk_bf16(v1[2], v1[3]); }
                    const int c = bj * HALF + tc0; int col;
                    if (pn < 2) col = C_DQ + (pn * 2 + bj) * 192 + tc0;
                    else if (pn == 2) col = C_DQ + (c >> 6) * 192 + 128 + (c & 63);
                    else if (pn < 5) col = C_DK + ((pn - 3) * 2 + bj) * 192 + tc0;
                    else col = C_DV + (pn - 5) * 256 + c;
                    *(u32x4*)(act + (size_t)row * LDACT + col) = w; } }
    }
};
struct EpiMerge {
    static constexpr bool PERM = true;
    bf16_t* gates;
    __device__ __forceinline__ void operator()(const f32x4 (&acc)[2][2][4][2], const Unit& u, int wr, int wc, int fr, int fq) const {
        const int row0 = u.pm * BM + wr * 64 + fr, tc0 = wc * 32 + 8 * fq;
#pragma unroll
        for (int ai = 0; ai < 2; ++ai)
#pragma unroll
            for (int m = 0; m < 4; ++m) { bf16_t* rowp = gates + (size_t)(row0 + ai * HALF + m * 16) * 8192 + u.pn * 256 + tc0;
                u32x4 gv[2];
#pragma unroll
                for (int bj = 0; bj < 2; ++bj) gv[bj] = *(const u32x4*)(rowp + bj * HALF);
#pragma unroll
                for (int bj = 0; bj < 2; ++bj) { const f32x4 v0 = acc[ai][bj][m][0], v1 = acc[ai][bj][m][1]; const u32x4 g = gv[bj]; u32x4 w;
                    w.x = cvt_pk_bf16(v0[0] * bf_lo(g.x), v0[1] * bf_hi(g.x)); w.y = cvt_pk_bf16(v0[2] * bf_lo(g.y), v0[3] * bf_hi(g.y));
                    w.z = cvt_pk_bf16(v1[0] * bf_lo(g.z), v1[1] * bf_hi(g.z)); w.w = cvt_pk_bf16(v1[2] * bf_lo(g.w), v1[3] * bf_hi(g.w));
                    *(u32x4*)(rowp + bj * HALF) = w; } }
    }
};
struct EpiRes {
    static constexpr bool PERM = false;
    const float* x; float* pre; const float* gvec;
    __device__ __forceinline__ void operator()(const f32x4 (&acc)[2][2][4][2], const Unit& u, int wr, int wc, int fr, int fq) const {
        const int row0 = u.pm * BM + wr * 64 + fr, col0 = u.pn * BM + wc * 32 + 4 * fq;
        const float* gp = gvec + (size_t)(u.pm < 32 ? (u.pm >> 3) : 4) * (6 * DM) + col0;
        f32x4 gv[2][2];
#pragma unroll
        for (int bj = 0; bj < 2; ++bj)
#pragma unroll
            for (int n = 0; n < 2; ++n) gv[bj][n] = *(const f32x4*)(gp + bj * HALF + n * 16);
#pragma unroll
        for (int ai = 0; ai < 2; ++ai)
#pragma unroll
            for (int m = 0; m < 4; ++m) { const size_t off = (size_t)(row0 + ai * HALF + m * 16) * DM + col0;
#pragma unroll
                for (int bj = 0; bj < 2; ++bj)
#pragma unroll
                    for (int n = 0; n < 2; ++n) { const f32x4 xv = *(const f32x4*)(x + off + bj * HALF + n * 16);
                        *(f32x4*)(pre + off + bj * HALF + n * 16) = xv * ALPHA + gv[bj][n] * acc[ai][bj][m][n]; }
                asm volatile("" ::: "memory"); }
    }
};
struct EpiSwi {
    static constexpr bool PERM = true;
    bf16_t* fh;
    __device__ __forceinline__ void operator()(const f32x4 (&acc)[2][2][4][2], const Unit& u, int wr, int wc, int fr, int fq) const {
        const int row0 = u.pm * BM + wr * 64 + fr, col0 = u.pn * 128 + wc * 32 + 8 * fq;
#pragma unroll
        for (int ai = 0; ai < 2; ++ai)
#pragma unroll
            for (int m = 0; m < 4; ++m) { const f32x4 g0 = acc[ai][0][m][0], g1 = acc[ai][0][m][1], u0 = acc[ai][1][m][0], u1 = acc[ai][1][m][1]; u32x4 w;
                w.x = cvt_pk_bf16(g0[0] * fast_sigmoid(g0[0]) * u0[0], g0[1] * fast_sigmoid(g0[1]) * u0[1]);
                w.y = cvt_pk_bf16(g0[2] * fast_sigmoid(g0[2]) * u0[2], g0[3] * fast_sigmoid(g0[3]) * u0[3]);
                w.z = cvt_pk_bf16(g1[0] * fast_sigmoid(g1[0]) * u1[0], g1[1] * fast_sigmoid(g1[1]) * u1[1]);
                w.w = cvt_pk_bf16(g1[2] * fast_sigmoid(g1[2]) * u1[2], g1[3] * fast_sigmoid(g1[3]) * u1[3]);
                *(u32x4*)(fh + (size_t)(row0 + ai * HALF + m * 16) * FF + col0) = w; }
    }
};
}

namespace att {
constexpr int NW = 8, QBLK = 32, KVBLK = 64;
constexpr int SHM_V = KVBLK * 128 * 2;
#define SBAR() __builtin_amdgcn_sched_barrier(0)
__device__ __forceinline__ int crow(int r, int hi) { return (r & 3) + 8 * (r >> 2) + 4 * hi; }
__device__ __forceinline__ int v_st(int k, int c) { const int kk = (k & ~0xC) | ((k & 4) << 1) | ((k & 8) >> 1); return ((kk >> 3) * 4 + (c >> 5)) * 512 + ((kk & 7) * 32 + (c & 31)) * 2; }
__device__ __forceinline__ int v_rd_base(int lane) { return ((lane & 3) << 3) | (((lane >> 2) & 3) << 6) | (((lane >> 4) & 1) << 5) | (((lane >> 5) & 1) << 8); }
constexpr int v_rd_off(int d0, int ks, int half) { return d0 * 512 + ks * 4096 + half * 2048; }
template <int OFF> __device__ __forceinline__ s16x4 tr_read(int vb) { s16x4 r; asm volatile("ds_read_b64_tr_b16 %0, %1 offset:%2" : "=&v"(r) : "v"(vb), "i"(OFF) : "memory"); return r; }
template <int D0> __device__ __forceinline__ void pv_one(f32x16& od, int vb, bf16x8 pa0, bf16x8 pa1, bf16x8 pa2, bf16x8 pa3) {
    const s16x4 l0 = tr_read<v_rd_off(D0, 0, 0)>(vb), h0 = tr_read<v_rd_off(D0, 0, 1)>(vb), l1 = tr_read<v_rd_off(D0, 1, 0)>(vb), h1 = tr_read<v_rd_off(D0, 1, 1)>(vb);
    const s16x4 l2 = tr_read<v_rd_off(D0, 2, 0)>(vb), h2 = tr_read<v_rd_off(D0, 2, 1)>(vb), l3 = tr_read<v_rd_off(D0, 3, 0)>(vb), h3 = tr_read<v_rd_off(D0, 3, 1)>(vb);
    asm volatile("s_waitcnt lgkmcnt(0)" ::: "memory"); SBAR();
#define PK(L, H) (bf16x8){L[0], L[1], L[2], L[3], H[0], H[1], H[2], H[3]}
    od = __builtin_amdgcn_mfma_f32_32x32x16_bf16(pa0, PK(l0, h0), od, 0, 0, 0);
    od = __builtin_amdgcn_mfma_f32_32x32x16_bf16(pa1, PK(l1, h1), od, 0, 0, 0);
    od = __builtin_amdgcn_mfma_f32_32x32x16_bf16(pa2, PK(l2, h2), od, 0, 0, 0);
    od = __builtin_amdgcn_mfma_f32_32x32x16_bf16(pa3, PK(l3, h3), od, 0, 0, 0);
#undef PK
}
__device__ __forceinline__ void pv_d0(f32x16* o, int vb, bf16x8 pa0, bf16x8 pa1, bf16x8 pa2, bf16x8 pa3) {
    pv_one<0>(o[0], vb, pa0, pa1, pa2, pa3); pv_one<1>(o[1], vb, pa0, pa1, pa2, pa3); pv_one<2>(o[2], vb, pa0, pa1, pa2, pa3); pv_one<3>(o[3], vb, pa0, pa1, pa2, pa3);
}
template <bool BAND>
__device__ __forceinline__ void partialSM(f32x16& p0, f32x16& p1, float& m_reg, float& mn, float& alpha, const float C, const float thr, bool domask, int dk, int hi) {
    if (BAND) { if (domask) {
#pragma unroll
        for (int r = 0; r < 16; ++r) { const int kk = dk + crow(r, hi); if ((unsigned)(kk + 128) > 256u) p0[r] = -1e30f; if ((unsigned)(kk + 160) > 256u) p1[r] = -1e30f; } } }
    float pmax = p0[0];
#pragma unroll
    for (int r = 1; r < 16; ++r) pmax = fmaxf(pmax, p0[r]);
#pragma unroll
    for (int r = 0; r < 16; ++r) pmax = fmaxf(pmax, p1[r]);
    { auto rr = __builtin_amdgcn_permlane32_swap(__float_as_uint(pmax), __float_as_uint(pmax), false, false); pmax = fmaxf(__uint_as_float(rr[0]), __uint_as_float(rr[1])); }
    if (__builtin_expect(__all(pmax - m_reg <= thr), 1)) { mn = m_reg; alpha = 1.f; }
    else { mn = fmaxf(m_reg, pmax); alpha = __builtin_amdgcn_exp2f((m_reg - mn) * C); m_reg = mn; }
    const float mnC = -mn * C;
#pragma unroll
    for (int r = 0; r < 16; ++r) p0[r] = fmaf(p0[r], C, mnC);
#pragma unroll
    for (int r = 0; r < 16; ++r) p1[r] = fmaf(p1[r], C, mnC);
#pragma unroll
    for (int r = 0; r < 16; ++r) p0[r] = __builtin_amdgcn_exp2f(p0[r]);
}
__device__ __forceinline__ void finishSM(f32x16& p0, f32x16& p1, float alpha, float& l_reg, bf16x8& pa0, bf16x8& pa1, bf16x8& pa2, bf16x8& pa3) {
#pragma unroll
    for (int r = 0; r < 16; ++r) p1[r] = __builtin_amdgcn_exp2f(p1[r]);
    float ps = 0;
#pragma unroll
    for (int r = 0; r < 16; ++r) ps += p0[r];
#pragma unroll
    for (int r = 0; r < 16; ++r) ps += p1[r];
    { auto rr = __builtin_amdgcn_permlane32_swap(__float_as_uint(ps), __float_as_uint(ps), false, false); ps = __uint_as_float(rr[0]) + __uint_as_float(rr[1]); }
    l_reg = l_reg * alpha + ps;
#define PK4(P, BASE, OUT) do { unsigned a0 = cvt_pk_bf16(P[BASE + 0], P[BASE + 1]), a1 = cvt_pk_bf16(P[BASE + 2], P[BASE + 3]);   \
    unsigned b0 = cvt_pk_bf16(P[BASE + 4], P[BASE + 5]), b1 = cvt_pk_bf16(P[BASE + 6], P[BASE + 7]);                              \
    auto r0 = __builtin_amdgcn_permlane32_swap(a0, b0, false, false); auto r1 = __builtin_amdgcn_permlane32_swap(a1, b1, false, false); \
    u32x4 w = {r0[0], r1[0], r0[1], r1[1]}; OUT = *reinterpret_cast<bf16x8*>(&w); } while (0)
    PK4(p0, 0, pa0); PK4(p0, 8, pa1); PK4(p1, 0, pa2); PK4(p1, 8, pa3);
#undef PK4
}
#define KSWZP(row, colB, PITCH) ((row) * (PITCH) + ((colB) ^ (((row) & 7) << 4)))
template <int DQK>
__device__ __forceinline__ void qkt(f32x16& p0, f32x16& p1, const char* Ks, const bf16x8* qr, int r32, int hi) {
    p0 = f32x16{}; p1 = f32x16{};
#pragma unroll
    for (int d0 = 0; d0 < DQK / 16; ++d0) { const int cb = (d0 * 16 + hi * 8) * 2;
        const bf16x8 b0 = *reinterpret_cast<const bf16x8*>(Ks + KSWZP(r32, cb, DQK * 2));
        const bf16x8 b1 = *reinterpret_cast<const bf16x8*>(Ks + KSWZP(32 + r32, cb, DQK * 2));
        p0 = __builtin_amdgcn_mfma_f32_32x32x16_bf16(b0, qr[d0], p0, 0, 0, 0);
        p1 = __builtin_amdgcn_mfma_f32_32x32x16_bf16(b1, qr[d0], p1, 0, 0, 0); }
}
struct UnitArgs {
    const bf16_t* Qb; int ldq;
    const bf16_t* Kb; int ldk;
    const bf16_t* Vb; int ldv;
    int crow0, lrow0, ntc, nt;
    int dpos;
    float sink;
    bf16_t* out; int ldo;
    float* scr;
    float lam, omli; const float* gsub;
    int epi;
};
template <int DQK, bool BAND, bool SINK, int EPI>
__device__ __forceinline__ void attn_unit(const UnitArgs& a, char* lds) {
    constexpr int SDEPTH = (DQK == 192) ? 1 : 2;
    constexpr int NKC = DQK / 64, CH = DQK / 8, SHM_K = KVBLK * DQK * 2;
    constexpr float SCALE = (DQK == 64) ? 0.125f : (DQK == 128 ? 0.088388347648318440f : 0.072168783648703220f);
    constexpr float C = SCALE * 1.4426950408889634f, THRS = 8.0f / SCALE;
    int tid_ = threadIdx.x; asm volatile("" : "+v"(tid_));
    const int tid = tid_, wid = tid >> 6, lane = tid & 63, r32 = lane & 31, hi = lane >> 5;
    char* V_lds = lds; char* K_lds = lds + 2 * SHM_V;
    float* wsf = (float*)(lds + 2 * SHM_V + 2 * SHM_K) + wid * 64; float* li_l = wsf; float* al_l = wsf + 32;
    float m_reg = -1e30f, l_reg = 0; f32x16 o[4] = {}; bf16x8 qr[DQK / 16];
    const bf16_t* Qw = a.Qb + (long)(wid * QBLK + r32) * a.ldq + hi * 8;
#pragma unroll
    for (int d0 = 0; d0 < DQK / 16; ++d0) qr[d0] = *reinterpret_cast<const bf16x8*>(Qw + d0 * 16);
    const int sr = tid >> 4, sc = (tid & 15) * 8, vst0 = v_st(sr, sc), vst1 = v_st(32 + sr, sc);
#define KCOORD(q_, KR, KC) int t__ = tid; if constexpr (NKC == 3) asm volatile("" : "+v"(t__)); const int qq__ = t__ + 512 * (q_); const int KR = qq__ / CH, KC = (qq__ % CH) * 8;
    const int vb0 = (int)(uintptr_t)V_lds + v_rd_base(lane);
    struct { bf16x8 vs0, vs1, ks[NKC]; } sr_[SDEPTH];
    const int dk0 = a.dpos - wid * QBLK - r32;
#define TROW(j) (((j) < a.ntc) ? (a.crow0 + KVBLK * (j)) : (a.lrow0 + KVBLK * ((j) - a.ntc)))
#define SLOAD(i, j) do { const int R0_ = TROW(j); sr_[i].vs0 = *reinterpret_cast<const bf16x8*>(a.Vb + (long)(R0_ + sr) * a.ldv + sc); sr_[i].vs1 = *reinterpret_cast<const bf16x8*>(a.Vb + (long)(R0_ + 32 + sr) * a.ldv + sc); \
    _Pragma("unroll") for (int q_ = 0; q_ < NKC; ++q_) { KCOORD(q_, kr_, kc_) sr_[i].ks[q_] = *reinterpret_cast<const bf16x8*>(a.Kb + (long)(R0_ + kr_) * a.ldk + kc_); } } while (0)
#define SWRITE(b, i) do { *(bf16x8*)(V_lds + (b) * SHM_V + vst0) = sr_[i].vs0; *(bf16x8*)(V_lds + (b) * SHM_V + vst1) = sr_[i].vs1; \
    _Pragma("unroll") for (int q_ = 0; q_ < NKC; ++q_) { KCOORD(q_, kr_, kc_) *(bf16x8*)(K_lds + (b) * SHM_K + KSWZP(kr_, kc_ * 2, DQK * 2)) = sr_[i].ks[q_]; } } while (0)
#define SWAIT() do { if constexpr (SDEPTH == 2) { if constexpr (NKC == 1) asm volatile("s_waitcnt vmcnt(3)" ::: "memory"); else asm volatile("s_waitcnt vmcnt(4)" ::: "memory"); } else asm volatile("s_waitcnt vmcnt(0)" ::: "memory"); } while (0)
#define RESC(al) do { if (__any((al) < 1.f)) { if (hi == 0) al_l[r32] = (al); asm volatile("s_waitcnt lgkmcnt(0)" ::: "memory"); \
    _Pragma("unroll") for (int d = 0; d < 4; ++d) _Pragma("unroll") for (int r = 0; r < 16; ++r) o[d][r] *= al_l[crow(r, hi)]; } } while (0)
#define PSM(P0, P1, MN, AL, j) partialSM<BAND>(P0, P1, m_reg, MN, AL, C, THRS, (j) >= a.ntc, dk0 + KVBLK * ((j) - a.ntc), hi)
    f32x16 pA0, pA1, pB0, pB1; float mnA, mnB, alA, alB; bf16x8 pa0, pa1, pa2, pa3; const int NT = a.nt;
    constexpr int SE = 0, SO = SDEPTH - 1;
    SLOAD(SE, 0); asm volatile("s_waitcnt vmcnt(0)" ::: "memory"); SWRITE(0, SE); __syncthreads();
    qkt<DQK>(pA0, pA1, K_lds, qr, r32, hi); PSM(pA0, pA1, mnA, alA, 0);
    SLOAD(SO, 1); if constexpr (SDEPTH == 2) { if (2 < NT) SLOAD(SE, 2); }
    SWAIT(); SWRITE(1, SO); __syncthreads();
    for (int j = 1; j + 1 < NT; j += 2) {
        SBAR(); qkt<DQK>(pB0, pB1, K_lds + SHM_K, qr, r32, hi);
        finishSM(pA0, pA1, alA, l_reg, pa0, pa1, pa2, pa3); SBAR();
        SLOAD(SO, j + SDEPTH); SBAR();
        pv_d0(o, vb0, pa0, pa1, pa2, pa3); PSM(pB0, pB1, mnB, alB, j);
        __syncthreads(); SWAIT(); SWRITE(0, SE);
        RESC(alB); __syncthreads();
        SBAR(); qkt<DQK>(pA0, pA1, K_lds, qr, r32, hi);
        finishSM(pB0, pB1, alB, l_reg, pa0, pa1, pa2, pa3); SBAR();
        if (SDEPTH == 1 || j + 3 < NT) SLOAD(SE, j + 1 + SDEPTH); SBAR();
        pv_d0(o, vb0 + SHM_V, pa0, pa1, pa2, pa3); PSM(pA0, pA1, mnA, alA, j + 1);
        __syncthreads(); SWAIT(); SWRITE(1, SO);
        RESC(alA); __syncthreads();
    }
    SBAR(); qkt<DQK>(pB0, pB1, K_lds + SHM_K, qr, r32, hi);
    finishSM(pA0, pA1, alA, l_reg, pa0, pa1, pa2, pa3); SBAR();
    pv_d0(o, vb0, pa0, pa1, pa2, pa3); PSM(pB0, pB1, mnB, alB, NT - 1);
    __syncthreads(); RESC(alB);
    finishSM(pB0, pB1, alB, l_reg, pa0, pa1, pa2, pa3); SBAR();
    pv_d0(o, vb0 + SHM_V, pa0, pa1, pa2, pa3);
    if (SINK) l_reg += __builtin_amdgcn_exp2f(a.sink * 1.4426950408889634f - m_reg * C);
    if (hi == 0) li_l[r32] = l_reg; asm volatile("s_waitcnt lgkmcnt(0)" ::: "memory");
    float rli[16];
#pragma unroll
    for (int r = 0; r < 16; ++r) rli[r] = __builtin_amdgcn_rcpf(li_l[crow(r, hi)]);
#define OROW(r) int orow = crow(r, hi); asm volatile("" : "+v"(orow));
    if (EPI == 0) {
        bf16_t* Ow = a.out + (long)(wid * QBLK) * a.ldo + r32;
#pragma unroll
        for (int r = 0; r < 16; ++r) { OROW(r) bf16_t* op = Ow + (long)orow * a.ldo;
#pragma unroll
            for (int d0 = 0; d0 < 4; ++d0) op[d0 * 32] = (bf16_t)(cvt_pk_bf16(o[d0][r] * rli[r], 0.f) & 0xffffu); }
    } else if (EPI == 1) {
        float* Sw = a.scr + (long)(wid * QBLK) * 512 + r32;
#pragma unroll
        for (int r = 0; r < 16; ++r) { OROW(r) float* sp = Sw + (long)orow * 512;
#pragma unroll
            for (int d0 = 0; d0 < 4; ++d0) sp[d0 * 32] = o[d0][r] * rli[r]; }
        asm volatile("s_waitcnt vmcnt(0)" ::: "memory");
    } else {
        const float* Sw = a.scr + (long)(wid * QBLK) * 512 + r32; bf16_t* Ow = a.out + (long)(wid * QBLK) * a.ldo + r32;
#pragma unroll
        for (int r = 0; r < 16; ++r) { OROW(r) const float* sp = Sw + (long)orow * 512; bf16_t* op = Ow + (long)orow * a.ldo; float d[4]; float ss = 0.f;
#pragma unroll
            for (int d0 = 0; d0 < 4; ++d0) { d[d0] = sp[d0 * 32] - a.lam * (o[d0][r] * rli[r]); ss += d[d0] * d[d0]; }
            ss += __shfl_xor(ss, 1); ss += __shfl_xor(ss, 2); ss += __shfl_xor(ss, 4); ss += __shfl_xor(ss, 8); ss += __shfl_xor(ss, 16);
            const float rs = __builtin_amdgcn_rsqf(ss * (1.0f / 128.0f) + NORM_EPS) * a.omli;
#pragma unroll
            for (int d0 = 0; d0 < 4; ++d0) op[d0 * 32] = (bf16_t)(cvt_pk_bf16(d[d0] * rs * a.gsub[d0 * 32 + r32], 0.f) & 0xffffu);
            if ((r & 3) == 3) asm volatile("" ::: "memory"); }
    }
#undef OROW
    __syncthreads();
#undef TROW
#undef KCOORD
#undef SLOAD
#undef SWRITE
#undef SWAIT
#undef RESC
#undef PSM
}
}

#define XB_TMO      128
#define XB_XCNT(j)  (256  + 64 * (j))
#define XB_XSUB(j)  (1280 + 64 * (j))
#define XB_XGEN(j)  (2304 + 64 * (j))
#define XB_TOP      3328
#define XB_TOPGEN   3392
#define XCD_BAR_WORDS 3456
#define XB_SPIN_CAP (1u << 18)
__device__ __forceinline__ unsigned xb_ld(unsigned* p)              { return __hip_atomic_load(p, __ATOMIC_RELAXED, __HIP_MEMORY_SCOPE_AGENT); }
__device__ __forceinline__ unsigned xb_add(unsigned* p, unsigned v) { return __hip_atomic_fetch_add(p, v, __ATOMIC_RELAXED, __HIP_MEMORY_SCOPE_AGENT); }
__device__ __forceinline__ unsigned xb_xcc_id() { return (unsigned)__builtin_amdgcn_s_getreg((3 << 11) | 20) & 0xFu; }
#define XB_SPIN(cond, bar) do { unsigned _sp = 0; while (cond) { __builtin_amdgcn_s_sleep(1); \
    if ((++_sp & 255u) == 0u) { if (xb_ld(&(bar)[XB_TMO])) break; if (_sp > XB_SPIN_CAP) { atomicAdd(&(bar)[XB_TMO], 1u); break; } } } } while (0)
struct XcdBarrier { unsigned* bar; unsigned x; volatile LAS unsigned* st; };
__device__ __forceinline__ XcdBarrier xcd_barrier_post(unsigned* bar, volatile LAS unsigned* st) {
    XcdBarrier b; b.bar = bar; b.x = xb_xcc_id(); b.st = st;
    if (threadIdx.x == 0) (void)xb_add(&bar[XB_XCNT(b.x)], 1u);
    return b;
}
__device__ __forceinline__ void xcd_barrier_complete(unsigned* bar, unsigned x, unsigned& nloc, unsigned& nx) {
    const unsigned G = gridDim.x * gridDim.y * gridDim.z;
    unsigned sum, cnt, mine, sp = 0u;
    for (;;) {
        sum = 0u; cnt = 0u; mine = 0u;
#pragma unroll
        for (unsigned j = 0; j < 16; ++j) { const unsigned c = xb_ld(&bar[XB_XCNT(j)]); sum += c; cnt += (c > 0u) ? 1u : 0u; mine = (j == x) ? c : mine; }
        if (sum == G) break;
        __builtin_amdgcn_s_sleep(1);
        if ((++sp & 255u) == 0u) { if (xb_ld(&bar[XB_TMO])) break; if (sp > XB_SPIN_CAP) { atomicAdd(&bar[XB_TMO], 1u); break; } }
    }
    nloc = mine > 0u ? mine : 1u; nx = cnt > 0u ? cnt : 1u;
}
__device__ __forceinline__ void xcd_barrier(const XcdBarrier& b) {
    asm volatile("s_waitcnt vmcnt(0)" ::: "memory");
    __syncthreads();
    if (threadIdx.x == 0) {
        unsigned* bar = b.bar;
        __builtin_amdgcn_s_waitcnt(0);
        unsigned nloc = b.st[0], nx = b.st[1];
        if (nloc == 0u) { xcd_barrier_complete(bar, b.x, nloc, nx); b.st[0] = nloc; b.st[1] = nx; }
        const unsigned old = xb_add(&bar[XB_XSUB(b.x)], 1u);
        const unsigned gen = old / nloc;
        if (old + 1u == (gen + 1u) * nloc) {
            __builtin_amdgcn_fence(__ATOMIC_RELEASE, "agent");
            asm volatile("s_waitcnt vmcnt(0)" ::: "memory");
            const unsigned og = xb_add(&bar[XB_TOP], 1u);
            const unsigned tg = og / nx;
            if (og + 1u == (tg + 1u) * nx) xb_add(&bar[XB_TOPGEN], 1u);
            else XB_SPIN(xb_ld(&bar[XB_TOPGEN]) == tg, bar);
            __builtin_amdgcn_fence(__ATOMIC_ACQUIRE, "agent");
            xb_add(&bar[XB_XGEN(b.x)], 1u);
            asm volatile("s_waitcnt vmcnt(0)" ::: "memory");
        } else {
            XB_SPIN(xb_ld(&bar[XB_XGEN(b.x)]) == gen, bar);
            __builtin_amdgcn_fence(__ATOMIC_ACQUIRE, "agent");
            asm volatile("s_waitcnt vmcnt(0)" ::: "memory");
        }
    }
    __syncthreads();
}

struct Args {
    const float* in[23];
    float* out; unsigned char* ws;
    int ph_lo, ph_hi;
};
typedef const __attribute__((address_space(4))) Args* ArgsP;
enum { I_X = 0, I_C, I_CTX, I_CCTX, I_WADA, I_BADA, I_WIN, I_AQKN, I_BSINK, I_CLAM, I_CSUBLN, I_MQN, I_MWQ, I_MKVN, I_MWKV, I_WBR, I_WOUT, I_LMG, I_LMB, I_WFI, I_WFO, I_LFG, I_LFB };
constexpr int NPH_LAYER = 10, NPH_PRO = 2, NPH_TOTAL = NPH_PRO + DEPTH * NPH_LAYER;

template <class SrcFn>
__device__ __forceinline__ void cvt_item(const float* W, int K, int Nsrc, bf16_t* WT, const float* kscale, LAS float* scr, int kb, int nb, int lane, SrcFn srcf) {
    const int k0 = 64 * kb, n0 = 32 * nb; const int sc = srcf(n0 + (lane & 31));
#pragma unroll 8
    for (int i = 0; i < 32; ++i) { const int kk = 2 * i + (lane >> 5); float v = W[(size_t)(k0 + kk) * Nsrc + sc]; if (kscale) v *= kscale[k0 + kk]; scr[kk * 33 + (lane & 31)] = v; }
    asm volatile("s_waitcnt lgkmcnt(0)" ::: "memory");
    const int c = lane & 7;
#pragma unroll
    for (int j = 0; j < 4; ++j) { const int n = (lane >> 3) + 8 * j; const LAS float* s = scr + (8 * c) * 33 + n;
        u32x4 o; o.x = cvt_pk_bf16(s[0 * 33], s[1 * 33]); o.y = cvt_pk_bf16(s[2 * 33], s[3 * 33]); o.z = cvt_pk_bf16(s[4 * 33], s[5 * 33]); o.w = cvt_pk_bf16(s[6 * 33], s[7 * 33]);
        *(u32x4*)(WT + (size_t)(n0 + n) * K + k0 + 8 * c) = o; }
    asm volatile("s_waitcnt lgkmcnt(0)" ::: "memory");
}
constexpr int IT_IN = (DM / 64) * (NIN / 32), IT_QUP = (512 / 64) * (768 / 32), IT_KVUP = (512 / 64) * (1024 / 32), IT_BR = 4 * (512 / 64) * (DM / 32), IT_OUT = (DM / 64) * (DM / 32),
              IT_FI = (DM / 64) * (2 * FF / 32), IT_FO = (FF / 64) * (DM / 32), IT_LAYER = IT_IN + IT_QUP + IT_KVUP + IT_BR + IT_OUT + IT_FI + IT_FO;
__device__ __forceinline__ void convert_weights_item(ArgsP Ap, int it, LAS float* scr, int lane) {
    const auto& A = *Ap;
    const int l = it / IT_LAYER; int r = it % IT_LAYER;
    unsigned char* wl = A.ws + WS_W + (size_t)l * WL_SIZE;
    if (r < IT_IN) { const int nblk = NIN / 32; cvt_item(A.in[I_WIN] + (size_t)l * DM * NIN_SRC, DM, NIN_SRC, (bf16_t*)(wl + WL_IN), nullptr, scr, r / nblk, r % nblk, lane, [](int n) { return win_src(n); }); return; } r -= IT_IN;
    if (r < IT_QUP) { const int nblk = 768 / 32; cvt_item(A.in[I_MWQ] + (size_t)l * 512 * 768, 512, 768, (bf16_t*)(wl + WL_UP), A.in[I_MQN] + l * 512, scr, r / nblk, r % nblk, lane,
        [](int n) { return n < 512 ? (n >> 7) * 192 + (n & 127) : ((n - 512) >> 6) * 192 + 128 + L64((n - 512) & 63); }); return; } r -= IT_QUP;
    if (r < IT_KVUP) { const int nblk = 1024 / 32; cvt_item(A.in[I_MWKV] + (size_t)l * 512 * 1024, 512, 1024, (bf16_t*)(wl + WL_UP) + (size_t)768 * 512, A.in[I_MKVN] + l * 512, scr, r / nblk, r % nblk, lane,
        [](int n) { return n < 512 ? (n >> 7) * 256 + (n & 127) : ((n - 512) >> 7) * 256 + 128 + ((n - 512) & 127); }); return; } r -= IT_KVUP;
    if (r < IT_BR) { const int per = IT_BR / 4, m = r / per, rr = r % per, nblk = DM / 32;
        cvt_item(A.in[I_WBR] + ((size_t)l * 4 + m) * 512 * DM, 512, DM, (bf16_t*)(wl + WL_BR) + (size_t)m * DM * 512, nullptr, scr, rr / nblk, rr % nblk, lane, [](int n) { return n; }); return; } r -= IT_BR;
    if (r < IT_OUT) { const int nblk = DM / 32; cvt_item(A.in[I_WOUT] + (size_t)l * DM * DM, DM, DM, (bf16_t*)(wl + WL_OUT), nullptr, scr, r / nblk, r % nblk, lane, [](int n) { return n; }); return; } r -= IT_OUT;
    if (r < IT_FI) { const int nblk = 2 * FF / 32; cvt_item(A.in[I_WFI] + (size_t)l * DM * 2 * FF, DM, 2 * FF, (bf16_t*)(wl + WL_FI), nullptr, scr, r / nblk, r % nblk, lane,
        [](int n) { const int t = n >> 8, w = n & 255; return w < 128 ? t * 128 + w : FF + t * 128 + (w - 128); }); return; } r -= IT_FI;
    { const int nblk = DM / 32; cvt_item(A.in[I_WFO] + (size_t)l * FF * DM, FF, DM, (bf16_t*)(wl + WL_FO), nullptr, scr, r / nblk, r % nblk, lane, [](int n) { return n; }); }
}
__device__ __forceinline__ void ada_unit(ArgsP Ap, int unit, LAS unsigned char* lds, int tid) {
    const auto& A = *Ap;
    LAS float* sl = (LAS float*)lds;
    LAS float* red = (LAS float*)(lds + 40960);
    const int l = unit / 48, cb = unit % 48, wid = tid >> 6, lane = tid & 63;
    for (int i = tid; i < 5 * DM; i += 512) { const int r = i / DM, k = i % DM; const float v = r < 4 ? A.in[I_C][r * DM + k] : A.in[I_CCTX][k]; sl[i] = v / (1.0f + __expf(-v)); }
    __syncthreads();
    const float* W = A.in[I_WADA] + (size_t)l * DM * (6 * DM) + cb * 256 + lane * 4;
    f32x4 acc[5];
#pragma unroll
    for (int r = 0; r < 5; ++r) acc[r] = (f32x4){0.f, 0.f, 0.f, 0.f};
    const int kbeg = wid * 256;
    for (int k = kbeg; k < kbeg + 256; k += 8) {
        f32x4 w[8];
#pragma unroll
        for (int j = 0; j < 8; ++j) w[j] = *(const f32x4*)(W + (size_t)(k + j) * (6 * DM));
#pragma unroll
        for (int j = 0; j < 8; ++j)
#pragma unroll
            for (int r = 0; r < 5; ++r) { const float s = sl[r * DM + k + j]; acc[r] += w[j] * s; }
    }
#pragma unroll
    for (int r = 0; r < 5; ++r) *(LAS f32x4*)(red + (wid * 5 + r) * 256 + lane * 4) = acc[r];
    __syncthreads();
    for (int i = tid; i < 5 * 256; i += 512) { const int r = i / 256, c = i % 256; float s = 0.f;
#pragma unroll
        for (int w = 0; w < 8; ++w) s += red[(w * 5 + r) * 256 + c];
        const int col = cb * 256 + c;
        ((float*)(A.ws + WS_ADA))[((size_t)l * 5 + r) * (6 * DM) + col] = s + A.in[I_BADA][(size_t)l * 6 * DM + col]; }
    __syncthreads();
}
__device__ __forceinline__ void ln_row(const float* src, float* xdst, bf16_t* hdst, const float* gam, const float* bet, const float* sc, const float* sh, int lane_) {
    int lane = lane_; asm volatile("" : "+v"(lane));
    f32x4 v[8]; float s = 0.f;
#pragma unroll
    for (int j = 0; j < 8; ++j) { v[j] = *(const f32x4*)(src + 256 * j + 4 * lane); s += (v[j][0] + v[j][1]) + (v[j][2] + v[j][3]); }
    const float mean = wave_sum(s) * (1.0f / DM); float q = 0.f;
#pragma unroll
    for (int j = 0; j < 8; ++j) { v[j] = v[j] - mean; q += (v[j][0] * v[j][0] + v[j][1] * v[j][1]) + (v[j][2] * v[j][2] + v[j][3] * v[j][3]); }
    const float rstd = 1.0f / sqrtf(wave_sum(q) * (1.0f / DM) + NORM_EPS);
#pragma unroll
    for (int j = 0; j < 8; ++j) { const int c = 256 * j + 4 * lane; f32x4 y = v[j] * rstd;
        if (gam) y = y * *(const f32x4*)(gam + c) + *(const f32x4*)(bet + c);
        *(f32x4*)(xdst + c) = y;
        if (hdst) { const f32x4 h = y * (*(const f32x4*)(sc + c) + 1.0f) + *(const f32x4*)(sh + c); u32x2 w; w.x = cvt_pk_bf16(h[0], h[1]); w.y = cvt_pk_bf16(h[2], h[3]); *(u32x2*)(hdst + c) = w; } }
}

__device__ __forceinline__ ArgsP args_ptr() { ArgsP p = (ArgsP)__builtin_amdgcn_kernarg_segment_ptr(); asm volatile("" : "+s"(p)); return p; }
#define WSP(T, off) ((T*)(ws + (off)))
#define PH_ENTER() ArgsP ap = args_ptr(); unsigned char* ws = ap->ws; int Gp = (int)gridDim.x, bxp = (int)blockIdx.x; asm volatile("" : "+s"(Gp), "+s"(bxp)); (void)Gp; (void)bxp

__global__ void __launch_bounds__(512, 2) mk_fwd(Args Aarg) {
    extern __shared__ __attribute__((aligned(16))) unsigned char lds_raw[];
    LAS unsigned char* lds = (LAS unsigned char*)lds_raw;
    const int tid = threadIdx.x, lane = tid & 63, wid = __builtin_amdgcn_readfirstlane(tid >> 6);
    const int G = gridDim.x, bx = blockIdx.x;
    volatile LAS unsigned* MISC = (volatile LAS unsigned*)(lds + LDSCTL_OFF);
    for (int u = tid; u < 256; u += 512) ((LAS unsigned*)(lds + LDSCTL_OFF))[u] = 0u;
    __syncthreads();
    XcdBarrier bar; bar.bar = nullptr; bar.x = 0; bar.st = nullptr;
    if (MK_N_LAUNCHES == 1) bar = xcd_barrier_post((unsigned*)(Aarg.ws + WS_CTL) + CW_BAR, MISC + 8);
    const int lo = Aarg.ph_lo, hi = Aarg.ph_hi;
#ifndef PHMASK
#define PHMASK 0xFFFFFFFFu
#endif
#define IN(k) (lo <= (k) && (k) < hi)
#define PHON(b) ((PHMASK >> (b)) & 1u)
#define SEAM(k) do { if (MK_N_LAUNCHES == 1 && (k) + 1 < hi) xcd_barrier(bar); } while (0)
    const int gw = bx * 8 + wid, NGW = G * 8;

    if (PHON(0) && IN(0)) {
        PH_ENTER();
        for (int u = bx; u < DEPTH * 48; u += G) ada_unit(ap, u, lds, tid);
        for (int i = bx * 512 + tid; i < SEQ * 96; i += G * 512) {
            const int t = i / 96, e = i % 96;
            if (e < 64) { const int ax = e >> 5, f = e & 31; const float pos = ax ? (float)(t & 63) : (float)(t >> 6); const float ang = pos * powf(10000.0f, -(float)f / 32.0f);
                WSP(f32x2, WS_T128)[(size_t)t * 64 + e] = (f32x2){cosf(ang), sinf(ang)}; }
            else { const int e2 = e - 64, ax = e2 >> 4, f = e2 & 15; const float pos = ax ? (float)(t & 63) : (float)(t >> 6); const float ang = pos * powf(10000.0f, -(float)f / 16.0f);
                WSP(f32x2, WS_T64)[(size_t)t * 32 + e2] = (f32x2){cosf(ang), sinf(ang)}; }
        }
        if (bx == 0 && wid < DEPTH) { const float* cl = ap->in[I_CLAM] + wid * 256; const float s1 = wave_sum(cl[lane] * cl[64 + lane]), s2 = wave_sum(cl[128 + lane] * cl[192 + lane]);
            if (lane == 0) WSP(float, WS_LAM)[wid] = expf(s1) - expf(s2) + (0.8f - 0.6f * expf(-0.3f * (float)wid)); }
        { LAS float* scr = (LAS float*)(lds + wid * 16384);
          for (int it = gw; it < DEPTH * IT_LAYER; it += NGW) convert_weights_item(ap, it, scr, lane); }
        SEAM(0);
    }
    if (PHON(1) && IN(1)) {
        PH_ENTER(); const float* xin = ap->in[I_X]; const float* cin = ap->in[I_CTX];
        for (int row = gw; row < MT; row += NGW) {
            const float* src = row < ML ? xin + (size_t)row * DM : cin + (size_t)(row - ML) * DM;
            const float* ad = WSP(float, WS_ADA) + (size_t)(row < ML ? (row >> 11) : 4) * (6 * DM);
            ln_row(src, WSP(float, WS_X) + (size_t)row * DM, WSP(bf16_t, WS_HB) + (size_t)row * DM, nullptr, nullptr, ad + 1 * DM, ad + 0 * DM, lane);
        }
        SEAM(1);
    }
    for (int l = 0; l < DEPTH; ++l) {
        const int p0 = NPH_PRO + l * NPH_LAYER;
        if (hi <= p0 || lo >= p0 + NPH_LAYER) continue;
        const bool lastl = (l == DEPTH - 1);
        const int nMpost = lastl ? 32 : 36;
        if (PHON(2) && IN(p0 + 0)) {
            PH_ENTER();
            pg8::Gemm g{WSP(bf16_t, WS_HB), WSP(const bf16_t, WS_W + (size_t)l * WL_SIZE + WL_IN), DM, DM, DM}; pg8::Order<0> S; S.init(36, NIN / 256, Gp, bxp, DM, DM);
            pg8::EpiIn E{WSP(bf16_t, WS_ACT), WSP(bf16_t, WS_G), WSP(bf16_t, WS_DQKV), WSP(float, WS_SSQ), WSP(const f32x4, WS_T128), WSP(const f32x4, WS_T64), ap->in[I_AQKN] + l * 256, (LAS float*)(lds + XCH_OFF)};
            pg8::gemm_phase(lds, g, S, E);
            SEAM(p0 + 0);
        }
        if (PHON(3) && IN(p0 + 1)) {
            PH_ENTER();
            pg8::Gemm g{WSP(bf16_t, WS_DQKV), WSP(const bf16_t, WS_W + (size_t)l * WL_SIZE + WL_UP), 512, 512, 512}; pg8::Order<2> S; S.init(36, 7, Gp, bxp, 512, 512);
            pg8::EpiUp E{WSP(bf16_t, WS_ACT), WSP(float, WS_SSQ), WSP(const f32x4, WS_T64)};
            pg8::gemm_phase(lds, g, S, E);
            SEAM(p0 + 1);
        }
        if (PHON(4) && IN(p0 + 2)) {
            PH_ENTER();
            unsigned* qhead = WSP(unsigned, WS_CTL) + CW_QUEUE + 64 * l;
            bf16_t* ACT = WSP(bf16_t, WS_ACT); bf16_t* OUTS = WSP(bf16_t, WS_OUTS);
            const float lam = WSP(float, WS_LAM)[l], omli = 1.0f - (0.8f - 0.6f * expf(-0.3f * (float)l));
#define ATT_FETCH() do { if (tid == 0) MISC[16] = __hip_atomic_fetch_add(qhead, 1u, __ATOMIC_RELAXED, __HIP_MEMORY_SCOPE_AGENT); __syncthreads(); L = (int)MISC[16]; __syncthreads(); } while (0)
#define ATT_DECODE(base) const int r_ = L - (base); const bool isctx = r_ >= 128; const int b = isctx ? ((r_ - 128) >> 2) : (r_ >> 5), h = isctx ? (r_ & 3) : ((r_ >> 3) & 3), qb = isctx ? 0 : (r_ & 7); \
                const int qrow0 = isctx ? (ML + b * CTXL) : (b * SEQ + qb * 256); att::UnitArgs ua; ua.crow0 = ML + b * CTXL; ua.ntc = 4; ua.lrow0 = b * SEQ; ua.nt = isctx ? 4 : 36; ua.dpos = 0; ua.sink = 0.f; \
                ua.ldo = DM; ua.scr = WSP(float, WS_O1) + (size_t)qrow0 * 512 + h * 128; ua.lam = lam; ua.omli = omli; ua.gsub = ap->in[I_CSUBLN] + l * 128; ua.ldq = LDACT; ua.ldk = LDACT; ua.ldv = LDACT;
            int L; ATT_FETCH();
#ifndef ATTMASK
#define ATTMASK 15
#endif
            while ((ATTMASK & 1) && L < 144) {
                if (!(lastl && L >= 128)) { ATT_DECODE(0)
                    ua.Vb = ACT + C_CV + h * 128; ua.out = OUTS + (size_t)qrow0 * DM + 1024 + h * 128;
                    ua.Qb = ACT + (size_t)qrow0 * LDACT + C_CQ + h * 128; ua.Kb = ACT + C_CK + h * 128;
                    att::attn_unit<64, false, false, 1>(ua, (char*)lds_raw);
                    ua.Qb += 64; ua.Kb += 64;
                    att::attn_unit<64, false, false, 2>(ua, (char*)lds_raw); }
                ATT_FETCH();
            }
            while ((ATTMASK & 2) && L < 288) {
                if (!(lastl && L >= 272)) { ATT_DECODE(144)
                    ua.Qb = ACT + (size_t)qrow0 * LDACT + C_DQ + h * 192; ua.Kb = ACT + C_DK + h * 192; ua.Vb = ACT + C_DV + h * 128; ua.out = OUTS + (size_t)qrow0 * DM + 1536 + h * 128;
                    att::attn_unit<192, false, false, 0>(ua, (char*)lds_raw); }
                ATT_FETCH();
            }
            while ((ATTMASK & 4) && L < 432) {
                if (!(lastl && L >= 416)) { ATT_DECODE(288)
                    ua.Qb = ACT + (size_t)qrow0 * LDACT + C_AQ + h * 128; ua.Kb = ACT + C_AK + (h >> 1) * 128; ua.Vb = ACT + C_AV + (h >> 1) * 128; ua.out = OUTS + (size_t)qrow0 * DM + 0 + h * 128;
                    att::attn_unit<128, false, false, 0>(ua, (char*)lds_raw); }
                ATT_FETCH();
            }
            while ((ATTMASK & 8) && L < 576) {
                if (!(lastl && L >= 560)) { ATT_DECODE(432)
                    ua.Qb = ACT + (size_t)qrow0 * LDACT + C_BQ + h * 128; ua.Kb = ACT + C_BK + (h >> 1) * 128; ua.Vb = ACT + C_BV + (h >> 1) * 128; ua.out = OUTS + (size_t)qrow0 * DM + 512 + h * 128;
                    ua.sink = ap->in[I_BSINK][l * 4 + h];
                    if (!isctx) { const int t0 = (4 * qb - 2) < 0 ? 0 : (4 * qb - 2), t1 = (4 * qb + 5) > 31 ? 31 : (4 * qb + 5);
                        ua.lrow0 = b * SEQ + 64 * t0; ua.nt = 4 + (t1 - t0 + 1); ua.dpos = 64 * t0 - 256 * qb; }
                    att::attn_unit<128, true, true, 0>(ua, (char*)lds_raw); }
                ATT_FETCH();
            }
#undef ATT_FETCH
#undef ATT_DECODE
            SEAM(p0 + 2);
        }
        if (PHON(5) && IN(p0 + 3)) {
            PH_ENTER();
            pg8::Gemm g{WSP(bf16_t, WS_OUTS), WSP(const bf16_t, WS_W + (size_t)l * WL_SIZE + WL_BR), 512, DM, 512}; pg8::Order<1> S; S.init(nMpost, 32, Gp, bxp, DM, 512);
            pg8::EpiMerge E{WSP(bf16_t, WS_G)};
            pg8::gemm_phase(lds, g, S, E);
            SEAM(p0 + 3);
        }
        if (PHON(6) && IN(p0 + 4)) {
            PH_ENTER(); const bf16_t* GT = WSP(bf16_t, WS_G); bf16_t* Y = WSP(bf16_t, WS_Y);
            const int nchunk = nMpost * 256 * (DM / 8); int t_ = threadIdx.x; asm volatile("" : "+v"(t_));
            for (int i = bx * 512 + t_; i < nchunk; i += G * 512) { const int row = i >> 8, c8 = (i & 255) * 8; const bf16_t* zp = GT + (size_t)row * 8192 + c8;
                const u32x4 z0 = *(const u32x4*)zp, z1 = *(const u32x4*)(zp + 2048), z2 = *(const u32x4*)(zp + 4096), z3 = *(const u32x4*)(zp + 6144); u32x4 w;
#define S4(f) ((bf_lo(z0.f) + bf_lo(z1.f)) + (bf_lo(z2.f) + bf_lo(z3.f))), ((bf_hi(z0.f) + bf_hi(z1.f)) + (bf_hi(z2.f) + bf_hi(z3.f)))
                w.x = cvt_pk_bf16(S4(x)); w.y = cvt_pk_bf16(S4(y)); w.z = cvt_pk_bf16(S4(z)); w.w = cvt_pk_bf16(S4(w));
#undef S4
                *(u32x4*)(Y + (size_t)row * DM + c8) = w; }
            SEAM(p0 + 4);
        }
        if (PHON(7) && IN(p0 + 5)) {
            PH_ENTER();
            pg8::Gemm g{WSP(bf16_t, WS_Y), WSP(const bf16_t, WS_W + (size_t)l * WL_SIZE + WL_OUT), DM, DM, DM}; pg8::Order<0> S; S.init(nMpost, 8, Gp, bxp, DM, DM);
            pg8::EpiRes E{WSP(float, WS_X), WSP(float, WS_PRE), WSP(float, WS_ADA) + (size_t)l * 5 * (6 * DM) + 2 * DM};
            pg8::gemm_phase(lds, g, S, E);
            SEAM(p0 + 5);
        }
        if (PHON(8) && IN(p0 + 6)) {
            PH_ENTER(); const float* gam = ap->in[I_LMG] + l * DM; const float* bet = ap->in[I_LMB] + l * DM;
            for (int row = gw; row < nMpost * 256; row += NGW) { const float* ad = WSP(float, WS_ADA) + (size_t)l * 5 * (6 * DM) + (size_t)(row < ML ? (row >> 11) : 4) * (6 * DM);
                ln_row(WSP(float, WS_PRE) + (size_t)row * DM, WSP(float, WS_X) + (size_t)row * DM, WSP(bf16_t, WS_HB) + (size_t)row * DM, gam, bet, ad + 4 * DM, ad + 3 * DM, lane); }
            SEAM(p0 + 6);
        }
        if (PHON(9) && IN(p0 + 7)) {
            PH_ENTER();
            pg8::Gemm g{WSP(bf16_t, WS_HB), WSP(const bf16_t, WS_W + (size_t)l * WL_SIZE + WL_FI), DM, DM, DM}; pg8::Order<0> S; S.init(nMpost, 2 * FF / 256, Gp, bxp, DM, DM);
            pg8::EpiSwi E{WSP(bf16_t, WS_FH)};
            pg8::gemm_phase(lds, g, S, E);
            SEAM(p0 + 7);
        }
        if (PHON(10) && IN(p0 + 8)) {
            PH_ENTER();
            pg8::Gemm g{WSP(bf16_t, WS_FH), WSP(const bf16_t, WS_W + (size_t)l * WL_SIZE + WL_FO), FF, FF, FF}; pg8::Order<0> S; S.init(nMpost, 8, Gp, bxp, FF, FF);
            pg8::EpiRes E{WSP(float, WS_X), WSP(float, WS_PRE), WSP(float, WS_ADA) + (size_t)l * 5 * (6 * DM) + 5 * DM};
            pg8::gemm_phase(lds, g, S, E);
            SEAM(p0 + 8);
        }
        if (PHON(11) && IN(p0 + 9)) {
            PH_ENTER(); const float* gam = ap->in[I_LFG] + l * DM; const float* bet = ap->in[I_LFB] + l * DM;
            float* xo = lastl ? ap->out : WSP(float, WS_X);
            const float* adaN = WSP(float, WS_ADA) + (size_t)(lastl ? l : l + 1) * 5 * (6 * DM);
            for (int row = gw; row < nMpost * 256; row += NGW) { const float* ad = adaN + (size_t)(row < ML ? (row >> 11) : 4) * (6 * DM);
                ln_row(WSP(float, WS_PRE) + (size_t)row * DM, xo + (size_t)row * DM, lastl ? nullptr : WSP(bf16_t, WS_HB) + (size_t)row * DM, gam, bet, ad + 1 * DM, ad + 0 * DM, lane); }
            SEAM(p0 + 9);
        }
    }
#undef IN
#undef SEAM
}


#ifndef MK_DIAG
#define MK_DIAG 0
#endif
#if MK_DIAG
struct Reg { size_t off, bytes; };
__global__ void k_cksum(const unsigned char* ws, size_t off, size_t bytes, unsigned long long* slot) {
    const uint4* p = (const uint4*)(ws + off); const size_t n = bytes / 16; unsigned long long s = 0;
    for (size_t i = (size_t)blockIdx.x * blockDim.x + threadIdx.x; i < n; i += (size_t)gridDim.x * blockDim.x) { const uint4 v = p[i]; s += (unsigned long long)v.x * 3u + (unsigned long long)v.y * 5u + (unsigned long long)v.z * 7u + (unsigned long long)v.w * 11u + (i & 0xffff); }
    for (int o = 32; o >= 1; o >>= 1) s += __shfl_xor(s, o);
    if ((threadIdx.x & 63) == 0) atomicAdd(slot, s);
}
__global__ void k_diag_out(const unsigned long long* tab, int nph, float* out, int n) {
    int code = 0; for (int p = nph - 1; p >= 0; --p) if (tab[p] != tab[64 + p]) code = p + 1;
    for (int i = blockIdx.x * blockDim.x + threadIdx.x; i < n; i += gridDim.x * blockDim.x) out[i] = (i == 0) ? 1.0e6f * (float)code : 0.0f;
}
#endif
extern "C" void kernel_launch(void* const* d_in, const int* in_sizes, int n_in, void* d_out, int out_size, void* d_ws, size_t ws_size, hipStream_t stream) {
    static int grid = 0;
    if (grid == 0) {
        if (n_in != 23 || out_size != ML * DM || ws_size < WS_END) { fprintf(stderr, "kernel_launch: shape mismatch (n_in %d out %d ws %zu need %zu)\n", n_in, out_size, ws_size, (size_t)WS_END); grid = -1; return; }
        int dev = 0, cus = 0, per_cu = 0;
        if (hipGetDevice(&dev) != hipSuccess || hipDeviceGetAttribute(&cus, hipDeviceAttributeMultiprocessorCount, dev) != hipSuccess) { grid = -1; return; }
        if (hipFuncSetAttribute((const void*)mk_fwd, hipFuncAttributeMaxDynamicSharedMemorySize, LDS_BYTES) != hipSuccess) { fprintf(stderr, "kernel_launch: hipFuncSetAttribute failed\n"); grid = -1; return; }
        if (hipOccupancyMaxActiveBlocksPerMultiprocessor(&per_cu, (const void*)mk_fwd, 512, LDS_BYTES) != hipSuccess || per_cu < 1) { fprintf(stderr, "kernel_launch: occupancy query says %d\n", per_cu); }
        (void)hipGetLastError();
        grid = cus;
    }
    if (grid < 0) return;
    if (hipMemsetAsync((char*)d_ws + WS_CTL, 0, CTL_ZERO_BYTES, stream) != hipSuccess) return;
    Args a{};
    for (int i = 0; i < 23; ++i) a.in[i] = (const float*)d_in[i];
    a.out = (float*)d_out; a.ws = (unsigned char*)d_ws;
#if MK_DIAG
    {   unsigned long long* tab = (unsigned long long*)((char*)d_ws + WS_CTL + 512 * 1024);
        const int NP = DIAG_NP;
        for (int run = 0; run < 2; ++run) for (int p = 0; p < NP; ++p) {
            if (run == 1 && p == 0) hipMemsetAsync((char*)d_ws + WS_CTL, 0, 256 * 1024, stream);
            a.ph_lo = p; a.ph_hi = p + 1; hipLaunchKernelGGL(mk_fwd, dim3(grid), dim3(512), LDS_BYTES, stream, a);
            Reg regs[4]; int nr = 0; const int q = (p - 2) % 10;
            if (p == 0) { regs[nr++] = {WS_ADA, (size_t)DEPTH * 5 * 6 * DM * 4}; regs[nr++] = {WS_T128, 3 * MiB / 2}; regs[nr++] = {WS_LAM, 16}; regs[nr++] = {WS_W, DEPTH * WL_SIZE}; }
            else if (p == 1 || q == 6 || q == 9) { regs[nr++] = {WS_X, SZ_F32ROWS}; regs[nr++] = {WS_HB, SZ_BF16ROWS}; }
            else if (q == 0) { regs[nr++] = {WS_G, (size_t)MT * 8192 * 2}; regs[nr++] = {WS_DQKV, (size_t)2 * MT * 512 * 2}; regs[nr++] = {WS_SSQ, (size_t)MT * 16 * 4}; }
            else if (q == 1) { regs[nr++] = {WS_ACT, (size_t)MT * LDACT * 2}; }
            else if (q == 2) { regs[nr++] = {WS_OUTS, SZ_BF16ROWS}; regs[nr++] = {WS_O1, (size_t)MT * 512 * 4}; }
            else if (q == 3) { regs[nr++] = {WS_G, (size_t)MT * 8192 * 2}; }
            else if (q == 4) { regs[nr++] = {WS_Y, SZ_BF16ROWS}; }
            else if (q == 5 || q == 8) { regs[nr++] = {WS_PRE, SZ_F32ROWS}; }
            else if (q == 7) { regs[nr++] = {WS_FH, (size_t)MT * FF * 2}; }
            for (int r = 0; r < nr; ++r) hipLaunchKernelGGL(k_cksum, dim3(1024), dim3(256), 0, stream, (const unsigned char*)d_ws, regs[r].off, regs[r].bytes, tab + run * 64 + p);
        }
        hipLaunchKernelGGL(k_diag_out, dim3(1024), dim3(256), 0, stream, (const unsigned long long*)tab, NP, (float*)d_out, out_size);
        return;
    }
#endif
    if (MK_N_LAUNCHES == 1) { a.ph_lo = 0; a.ph_hi = NPH_TOTAL; hipLaunchKernelGGL(mk_fwd, dim3(grid), dim3(512), LDS_BYTES, stream, a); }
    else for (int p = 0; p < NPH_TOTAL; ++p) { a.ph_lo = p; a.ph_hi = p + 1; hipLaunchKernelGGL(mk_fwd, dim3(grid), dim3(512), LDS_BYTES, stream, a); }
    const hipError_t le = hipPeekAtLastError();
    if (le != hipSuccess) fprintf(stderr, "kernel_launch: launch failed: %s\n", hipGetErrorName(le));
}
```

```cpp
#include <hip/hip_runtime.h>
#include <cstdio>
#include <cstdint>

#ifndef MK_N_LAUNCHES
#define MK_N_LAUNCHES 1
#endif

#define LAS __attribute__((address_space(3)))
#define GAS __attribute__((address_space(1)))
typedef unsigned short bf16_t;
typedef short bf16x8 __attribute__((ext_vector_type(8)));
typedef short s16x4 __attribute__((ext_vector_type(4)));
typedef float f32x2 __attribute__((ext_vector_type(2)));
typedef float f32x4 __attribute__((ext_vector_type(4)));
typedef float f32x16 __attribute__((ext_vector_type(16)));
typedef unsigned u32x2 __attribute__((ext_vector_type(2)));
typedef unsigned u32x4 __attribute__((ext_vector_type(4)));

constexpr int DM = 2048, NBATCH = 4, SEQ = 2048, DEPTH = 4, CTXL = 256;
constexpr int ML = NBATCH * SEQ, MC = NBATCH * CTXL, MT = ML + MC;
constexpr int NIN_SRC = 12864, NIN = 13056;
constexpr int FF = 5632;
constexpr float NORM_EPS = 1e-6f;
constexpr float ALPHA = 1.681792830507429f;
constexpr int LDACT = 5632;
constexpr int C_AQ = 0, C_AK = 512, C_AV = 768, C_BQ = 1024, C_BK = 1536, C_BV = 1792, C_CQ = 2048, C_CK = 2560, C_CV = 3072, C_DQ = 3584, C_DK = 4352, C_DV = 5120;

constexpr size_t MiB = 1u << 20;
constexpr size_t WS_CTL = 0, CTL_ZERO_BYTES = 1 * MiB;
constexpr size_t WS_ADA = 1 * MiB;
constexpr size_t WS_T128 = 2 * MiB;
constexpr size_t WS_T64 = 3 * MiB;
constexpr size_t WS_LAM = 3 * MiB + 512 * 1024;
constexpr size_t WS_SSQ = 4 * MiB;
constexpr size_t WS_X = 8 * MiB;
constexpr size_t SZ_F32ROWS = (size_t)MT * DM * 4;
constexpr size_t WS_PRE = WS_X + SZ_F32ROWS;
constexpr size_t WS_HB = WS_PRE + SZ_F32ROWS;
constexpr size_t SZ_BF16ROWS = (size_t)MT * DM * 2;
constexpr size_t WS_ACT = WS_HB + SZ_BF16ROWS;
constexpr size_t WS_DQKV = WS_ACT + (size_t)MT * LDACT * 2;
constexpr size_t WS_G = WS_DQKV + (size_t)2 * MT * 512 * 2;
constexpr size_t WS_OUTS = WS_G + (size_t)MT * 8192 * 2;
constexpr size_t WS_Y = WS_OUTS + SZ_BF16ROWS;
constexpr size_t WS_FH = WS_Y + SZ_BF16ROWS;
constexpr size_t WS_O1 = WS_FH + (size_t)MT * FF * 2;
constexpr size_t WS_W = WS_O1 + (size_t)MT * 512 * 4;
constexpr size_t WL_IN = 0, WL_UP = WL_IN + (size_t)NIN * DM * 2, WL_BR = WL_UP + (size_t)1792 * 512 * 2, WL_OUT = WL_BR + (size_t)8192 * 512 * 2,
                 WL_FI = WL_OUT + (size_t)DM * DM * 2, WL_FO = WL_FI + (size_t)2 * FF * DM * 2, WL_SIZE = WL_FO + (size_t)DM * FF * 2;
constexpr size_t WS_END = WS_W + DEPTH * WL_SIZE;
static_assert(WS_SSQ + (size_t)MT * 16 * 4 <= WS_X && WS_ADA + (size_t)DEPTH * 5 * 6 * DM * 4 <= WS_T128, "ws map");
constexpr int CW_BAR = 4096;
constexpr int CW_QUEUE = 16384;

constexpr int RING_BYTES = 131072, LDSCTL_OFF = RING_BYTES, XCH_OFF = LDSCTL_OFF + 1024, LDS_BYTES = 147456;
static_assert(XCH_OFF + 8192 <= LDS_BYTES, "LDS map");

typedef __bf16 bf16x2_t __attribute__((ext_vector_type(2)));
__device__ __forceinline__ unsigned cvt_pk_bf16(float lo, float hi) { bf16x2_t v = {(__bf16)lo, (__bf16)hi}; return __builtin_bit_cast(unsigned, v); }
__device__ __forceinline__ float bf_lo(unsigned w) { return __uint_as_float(w << 16); }
__device__ __forceinline__ float bf_hi(unsigned w) { return __uint_as_float(w & 0xffff0000u); }
__device__ __forceinline__ float fast_sigmoid(float x) { return __builtin_amdgcn_rcpf(1.0f + __builtin_amdgcn_exp2f(-1.4426950408889634f * x)); }
__device__ __forceinline__ float wave_sum(float v) {
#pragma unroll
    for (int o = 1; o < 64; o <<= 1) v += __shfl_xor(v, o);
    return v;
}
__host__ __device__ __forceinline__ int L128(int p) { const int i = p >> 1, odd = p & 1; return i + 32 * odd + (i >= 32 ? 32 : 0); }
__host__ __device__ __forceinline__ int L64(int p) { const int i = p >> 1, odd = p & 1; return i + 16 * odd + (i >= 16 ? 16 : 0); }
__host__ __device__ __forceinline__ int win_src(int c) {
    const int t = c >> 8, w = c & 255;
    if (t >= 19) return 4672 + (c - 19 * 256);
    switch (t) {
        case 0: case 1: { const int cc = c; return 0 + (cc >> 7) * 128 + L128(cc & 127); }
        case 2: return 512 + (w >> 7) * 128 + L128(w & 127);
        case 3: return 768 + w;
        case 4: case 5: { const int cc = c - 1024; return 1024 + (cc >> 7) * 128 + L128(cc & 127); }
        case 6: return 1536 + (w >> 7) * 128 + L128(w & 127);
        case 7: return 1792 + w;
        case 8: case 9: { const int cc = c - 2048; return 2048 + (cc >> 6) * 64 + L64(cc & 63); }
        case 10: case 11: { const int cc = c - 2560; return 2560 + (cc >> 6) * 64 + L64(cc & 63); }
        case 12: case 13: return 3072 + (c - 3072);
        case 14: case 15: return 3584 + (c - 3584);
        case 16: case 17: return 4096 + (c - 4096);
        default: return 4608 + L64(w & 63);
    }
}

namespace pg8 {
constexpr int BM = 256, BK = 64, HALF = 128, HTB = HALF * BK * 2, STAGE_BYTES = 8 * HTB, NXCD = 8, WGM = 8;
__host__ __device__ __forceinline__ int lds_byte(int r, int c) { const int st = (r >> 4) * 2 + (c >> 5), rr = r & 15, cc = c & 31, ob = rr * 64 + cc * 2; return st * 1024 + (ob ^ (((ob >> 9) & 1) << 5)); }
__host__ __device__ __forceinline__ void stage_rc(int b, int& R, int& C) { const int st = b / 1024, sb = b % 1024, swz = sb ^ (((sb >> 9) & 1) << 5); R = (st >> 1) * 16 + swz / 64; C = (st & 1) * 32 + (swz % 64) / 2; }
__host__ __device__ __forceinline__ int perm32(int rho) { const int n = rho >> 4, i = rho & 15; return 8 * (i >> 2) + 4 * n + (i & 3); }
struct Unit { int pm, pn; };
struct Gemm { const bf16_t* A; const bf16_t* Bt; int K, lda, ldb; };
template <int AMODE  > struct Order {
    int nM, nN, nwg, G, c; int lda, ldb;
    __device__ void init(int nM_, int nN_, int G_, int c_, int lda_, int ldb_) { nM = nM_; nN = nN_; nwg = nM * nN; G = G_; c = c_; lda = lda_; ldb = ldb_; }
    __device__ bool next(int i, Unit& u) const {
        const long L = (long)i * G + c; if (L >= nwg) return false;
        int wgid = (int)L; { const int q = nwg / NXCD, r = nwg % NXCD, xcd = wgid % NXCD, off = wgid / NXCD; wgid = (xcd < r ? xcd * (q + 1) : r * (q + 1) + (xcd - r) * q) + off; }
        const int nig = WGM * nN, gid = wgid / nig, fm = gid * WGM, gsz = (nM - fm) < WGM ? (nM - fm) : WGM;
        u.pm = fm + ((wgid % nig) % gsz); u.pn = (wgid % nig) / gsz; return true;
    }
    __device__ __forceinline__ size_t a_off(const Unit& u) const {
        size_t o = (size_t)u.pm * BM * lda;
        if (AMODE == 1) o += (size_t)(u.pn >> 3) * 512;
        if (AMODE == 2) o += (u.pn >= 3) ? (size_t)MT * 512 : 0;
        return o;
    }
    __device__ __forceinline__ size_t b_off(const Unit& u) const { return (size_t)u.pn * BM * ldb; }
};

template <class Epi, class Sched>
__device__ __forceinline__ void gemm_phase(LAS unsigned char* lds, const Gemm g, const Sched& S, const Epi& E) {
    int tid_ = threadIdx.x; asm volatile("" : "+v"(tid_));
    const int tid = tid_, wid = __builtin_amdgcn_readfirstlane(tid >> 6), lane = tid & 63, wr = wid >> 2, wc = wid & 3, fr = lane & 15, fq = lane >> 4;
    const int K = g.K, nt = K / BK;
    unsigned voffA[2], voffB[2];
#pragma unroll
    for (int i = 0; i < 2; ++i) { int R, C; stage_rc(tid * 16 + i * 8192, R, C); const int Rb = Epi::PERM ? ((R & ~31) + perm32(R & 31)) : R;
        voffA[i] = (unsigned)(R * g.lda + C) * 2u; voffB[i] = (unsigned)(Rb * g.ldb + C) * 2u; }
    const size_t kstep = (size_t)(BK * 2);
    const size_t hstepA = (size_t)HALF * g.lda * 2, hstepB = (size_t)HALF * g.ldb * 2;
    const unsigned ldsw = (unsigned)wid * 1024u;
    const int aoff = lds_byte(wr * 64 + fr, fq * 8), boff = lds_byte(wc * 32 + fr, fq * 8);
#define PG8_SA(b, h) (((b) * 2 + (h)) * HTB)
#define PG8_SB(b, h) ((4 + (b) * 2 + (h)) * HTB)
#define PG8_STAGE(bufoff, gbase, voff) do { _Pragma("unroll") for (int _i = 0; _i < 2; ++_i) \
        __builtin_amdgcn_global_load_lds((const unsigned*)((const char*)(gbase) + (voff)[_i]), (LAS unsigned*)(lds + (bufoff) + ldsw + _i * 8192), 16, 0, 0); } while (0)
#define PG8_LDA(dst, b, h) do { _Pragma("unroll") for (int m = 0; m < 4; ++m) _Pragma("unroll") for (int k = 0; k < 2; ++k) dst[m][k] = *(const LAS bf16x8*)(lds + PG8_SA(b, h) + aoff + m * 2048 + k * 1024); } while (0)
#define PG8_LDB(dst, b, h) do { _Pragma("unroll") for (int n = 0; n < 2; ++n) _Pragma("unroll") for (int k = 0; k < 2; ++k) dst[n][k] = *(const LAS bf16x8*)(lds + PG8_SB(b, h) + boff + n * 2048 + k * 1024); } while (0)
#define PG8_MMA(ai, bj, At, Bt) do { __builtin_amdgcn_s_setprio(1); _Pragma("unroll") for (int m = 0; m < 4; ++m) _Pragma("unroll") for (int n = 0; n < 2; ++n) _Pragma("unroll") for (int k = 0; k < 2; ++k) \
        acc[ai][bj][m][n] = __builtin_amdgcn_mfma_f32_16x16x32_bf16(Bt[n][k], At[m][k], acc[ai][bj][m][n], 0, 0, 0); __builtin_amdgcn_s_setprio(0); } while (0)
#define PG8_WAIT_V(n) asm volatile("s_waitcnt vmcnt(" #n ")" ::: "memory")
#define PG8_WAIT_L(n) asm volatile("s_waitcnt lgkmcnt(" #n ")" ::: "memory")
#define PG8_BAR __builtin_amdgcn_s_barrier()
#define PG8_SCHED __builtin_amdgcn_sched_barrier(0)
    Unit cur, nxt; int ui = 0;
    if (!S.next(0, cur)) return;
    f32x4 acc[2][2][4][2];
#pragma unroll
    for (int a = 0; a < 2; ++a)
#pragma unroll
        for (int b = 0; b < 2; ++b)
#pragma unroll
            for (int m = 0; m < 4; ++m)
#pragma unroll
                for (int n = 0; n < 2; ++n) acc[a][b][m][n] = (f32x4){0.f, 0.f, 0.f, 0.f};
    bf16x8 At[4][2], B0[2][2], B1[2][2];
    const char* cA = (const char*)g.A + S.a_off(cur) * 2; const char* cB = (const char*)g.Bt + S.b_off(cur) * 2;
    PG8_STAGE(PG8_SB(0, 0), cB, voffB); PG8_STAGE(PG8_SB(0, 1), cB + hstepB, voffB); PG8_STAGE(PG8_SA(0, 0), cA, voffA); PG8_STAGE(PG8_SA(0, 1), cA + hstepA, voffA);
    if (wr == 1) PG8_BAR;
    PG8_WAIT_V(2); PG8_BAR;
    PG8_STAGE(PG8_SB(1, 0), cB + kstep, voffB); PG8_STAGE(PG8_SA(1, 0), cA + kstep, voffA); PG8_STAGE(PG8_SB(1, 1), cB + hstepB + kstep, voffB);
    PG8_WAIT_V(6); PG8_BAR;
    for (;;) {
        const bool has_next = S.next(ui + 1, nxt);
        const char* nA = has_next ? (const char*)g.A + S.a_off(nxt) * 2 : cA; const char* nB = has_next ? (const char*)g.Bt + S.b_off(nxt) * 2 : cB;
        for (int t = 0; t < nt; t += 2) {
            const bool last = (t == nt - 2);
            const char* a1 = cA + (size_t)(t + 1) * kstep;
            const char* a2 = last ? nA : cA + (size_t)(t + 2) * kstep; const char* b2 = last ? nB : cB + (size_t)(t + 2) * kstep;
            const char* a3 = a2 + kstep; const char* b3 = b2 + kstep;
            PG8_LDB(B0, 0, 0); PG8_LDB(B1, 0, 1); PG8_SCHED; PG8_LDA(At, 0, 0); PG8_STAGE(PG8_SA(1, 1), a1 + hstepA, voffA);
            PG8_WAIT_V(8); PG8_WAIT_L(0); PG8_BAR; PG8_MMA(0, 0, At, B0); PG8_MMA(0, 1, At, B1); PG8_BAR; PG8_SCHED;
            PG8_LDA(At, 0, 1); PG8_STAGE(PG8_SB(0, 0), b2, voffB); PG8_STAGE(PG8_SB(0, 1), b2 + hstepB, voffB); PG8_STAGE(PG8_SA(0, 0), a2, voffA);
            PG8_WAIT_V(8); PG8_WAIT_L(0); PG8_BAR; PG8_MMA(1, 0, At, B0); PG8_MMA(1, 1, At, B1); PG8_BAR; PG8_SCHED;
            PG8_LDB(B0, 1, 0); PG8_LDB(B1, 1, 1); PG8_SCHED; PG8_LDA(At, 1, 0); PG8_STAGE(PG8_SA(0, 1), a2 + hstepA, voffA);
            PG8_WAIT_V(8); PG8_WAIT_L(0); PG8_BAR; PG8_MMA(0, 0, At, B0); PG8_MMA(0, 1, At, B1); PG8_BAR; PG8_SCHED;
            PG8_LDA(At, 1, 1); PG8_STAGE(PG8_SB(1, 0), b3, voffB); PG8_STAGE(PG8_SB(1, 1), b3 + hstepB, voffB); PG8_STAGE(PG8_SA(1, 0), a3, voffA);
            PG8_WAIT_V(8); PG8_WAIT_L(0); PG8_BAR; PG8_MMA(1, 0, At, B0); PG8_MMA(1, 1, At, B1); PG8_BAR; PG8_SCHED;
        }
        if (wr == 0) PG8_BAR;
        E(acc, cur, wr, wc, fr, fq);
        if (!has_next) break;
#pragma unroll
        for (int a = 0; a < 2; ++a)
#pragma unroll
            for (int b = 0; b < 2; ++b)
#pragma unroll
                for (int m = 0; m < 4; ++m)
#pragma unroll
                    for (int n = 0; n < 2; ++n) acc[a][b][m][n] = (f32x4){0.f, 0.f, 0.f, 0.f};
        cur = nxt; cA = nA; cB = nB; ++ui;
        if (wr == 1) PG8_BAR;
    }
    PG8_WAIT_V(0);
    PG8_BAR;
#undef PG8_SA
#undef PG8_SB
#undef PG8_STAGE
#undef PG8_LDA
#undef PG8_LDB
#undef PG8_MMA
#undef PG8_WAIT_V
#undef PG8_WAIT_L
#undef PG8_BAR
#undef PG8_SCHED
}

struct EpiIn {
    static constexpr bool PERM = true;
    bf16_t* act; bf16_t* gates; bf16_t* dqkv; float* ssq; const f32x4* t128; const f32x4* t64; const float* qkn; LAS float* xch;
    __device__ __forceinline__ void operator()(const f32x4 (&acc)[2][2][4][2], const Unit& u, int wr, int wc, int fr, int fq) const {
        const int pn = u.pn, row0 = u.pm * BM + wr * 64 + fr, tc0 = wc * 32 + 8 * fq;
        if (pn >= 19) {
#pragma unroll
            for (int ai = 0; ai < 2; ++ai)
#pragma unroll
                for (int m = 0; m < 4; ++m) { bf16_t* rowp = gates + (size_t)(row0 + ai * HALF + m * 16) * 8192 + (pn - 19) * 256 + tc0;
#pragma unroll
                    for (int bj = 0; bj < 2; ++bj) { const f32x4 v0 = acc[ai][bj][m][0], v1 = acc[ai][bj][m][1]; u32x4 w;
                        w.x = cvt_pk_bf16(fast_sigmoid(v0[0]), fast_sigmoid(v0[1])); w.y = cvt_pk_bf16(fast_sigmoid(v0[2]), fast_sigmoid(v0[3]));
                        w.z = cvt_pk_bf16(fast_sigmoid(v1[0]), fast_sigmoid(v1[1])); w.w = cvt_pk_bf16(fast_sigmoid(v1[2]), fast_sigmoid(v1[3]));
                        *(u32x4*)(rowp + bj * HALF) = w; } }
            return;
        }
        const bool plain = (pn == 3) | (pn == 7) | (pn == 12) | (pn == 13) | (pn >= 14 && pn <= 17);
        if (plain) {
            bf16_t* base; int ld;
            if (pn >= 14) { base = dqkv + (pn >= 16 ? (size_t)MT * 512 : 0) + (pn & 1) * 256 + tc0; ld = 512; } else { base = act + pn * 256 + tc0; ld = LDACT; }
#pragma unroll
            for (int ai = 0; ai < 2; ++ai)
#pragma unroll
                for (int m = 0; m < 4; ++m) { const int row = row0 + ai * HALF + m * 16; bf16_t* rowp = base + (size_t)row * ld; float ss = 0.f;
#pragma unroll
                    for (int bj = 0; bj < 2; ++bj) { const f32x4 v0 = acc[ai][bj][m][0], v1 = acc[ai][bj][m][1]; u32x4 w;
                        ss += (v0[0] * v0[0] + v0[1] * v0[1]) + (v0[2] * v0[2] + v0[3] * v0[3]) + (v1[0] * v1[0] + v1[1] * v1[1]) + (v1[2] * v1[2] + v1[3] * v1[3]);
                        w.x = cvt_pk_bf16(v0[0], v0[1]); w.y = cvt_pk_bf16(v0[2], v0[3]); w.z = cvt_pk_bf16(v1[0], v1[1]); w.w = cvt_pk_bf16(v1[2], v1[3]);
                        *(u32x4*)(rowp + bj * HALF) = w; }
                    if (pn >= 14) { ss += __shfl_xor(ss, 16); ss += __shfl_xor(ss, 32); if (fq == 0) ssq[(size_t)row * 16 + (pn - 14) * 4 + wc] = ss; } }
            return;
        }
        const bool r128 = pn < 8, rms = pn < 3, lat = u.pm < 32;
        float gn[2][4];
        if (rms) { const float* gq = qkn + (pn == 2 ? 128 : 0);
#pragma unroll
            for (int n = 0; n < 2; ++n)
#pragma unroll
                for (int j = 0; j < 4; ++j) gn[n][j] = gq[L128(tc0 + 4 * n + j)];
#pragma unroll
            for (int ai = 0; ai < 2; ++ai)
#pragma unroll
                for (int m = 0; m < 4; ++m)
#pragma unroll
                    for (int bj = 0; bj < 2; ++bj) { const f32x4 v0 = acc[ai][bj][m][0], v1 = acc[ai][bj][m][1];
                        float ss = (v0[0] * v0[0] + v0[1] * v0[1]) + (v0[2] * v0[2] + v0[3] * v0[3]) + (v1[0] * v1[0] + v1[1] * v1[1]) + (v1[2] * v1[2] + v1[3] * v1[3]);
                        ss += __shfl_xor(ss, 16); ss += __shfl_xor(ss, 32);
                        if (fq == 0) xch[((ai * HALF + wr * 64 + m * 16 + fr) * 2 + bj) * 4 + wc] = ss; }
            asm volatile("s_waitcnt lgkmcnt(0)" ::: "memory"); __builtin_amdgcn_s_barrier(); asm volatile("" ::: "memory");
        }
        const int i0 = r128 ? (wc * 16 + 4 * fq) : ((wc & 1) * 16 + 4 * fq);
#pragma unroll
        for (int ai = 0; ai < 2; ++ai)
#pragma unroll
            for (int m = 0; m < 4; ++m) { const int row = row0 + ai * HALF + m * 16, t = row & (SEQ - 1);
                f32x4 cs0 = (f32x4){1.f, 0.f, 1.f, 0.f}, cs1 = cs0;
                if (lat) { const f32x4* tp = r128 ? (t128 + ((size_t)t * 64 + i0) / 2) : (t64 + ((size_t)t * 32 + i0) / 2); cs0 = tp[0]; cs1 = tp[1]; }
#pragma unroll
                for (int bj = 0; bj < 2; ++bj) { f32x4 v0 = acc[ai][bj][m][0], v1 = acc[ai][bj][m][1];
                    if (rms) { const f32x4 p = *(const LAS f32x4*)(xch + ((ai * HALF + wr * 64 + m * 16 + fr) * 2 + bj) * 4);
                        const float rs = __builtin_amdgcn_rsqf(((p[0] + p[1]) + (p[2] + p[3])) * (1.0f / 128.0f) + NORM_EPS);
                        v0[0] *= rs * gn[0][0]; v0[1] *= rs * gn[0][1]; v0[2] *= rs * gn[0][2]; v0[3] *= rs * gn[0][3];
                        v1[0] *= rs * gn[1][0]; v1[1] *= rs * gn[1][1]; v1[2] *= rs * gn[1][2]; v1[3] *= rs * gn[1][3]; }
                    const float a0 = v0[0] * cs0[0] - v0[1] * cs0[1], b0 = v0[1] * cs0[0] + v0[0] * cs0[1];
                    const float a1 = v0[2] * cs0[2] - v0[3] * cs0[3], b1 = v0[3] * cs0[2] + v0[2] * cs0[3];
                    const float a2 = v1[0] * cs1[0] - v1[1] * cs1[1], b2 = v1[1] * cs1[0] + v1[0] * cs1[1];
                    const float a3 = v1[2] * cs1[2] - v1[3] * cs1[3], b3 = v1[3] * cs1[2] + v1[2] * cs1[3];
                    u32x4 w; w.x = cvt_pk_bf16(a0, b0); w.y = cvt_pk_bf16(a1, b1); w.z = cvt_pk_bf16(a2, b2); w.w = cvt_pk_bf16(a3, b3);
                    bf16_t* dst;
                    if (pn == 18) { const int c = bj * HALF + tc0; dst = act + (size_t)row * LDACT + C_DK + (c >> 6) * 192 + 128 + (c & 63); }
                    else dst = act + (size_t)row * LDACT + pn * 256 + bj * HALF + tc0;
                    *(u32x4*)dst = w; } }
    }
};
struct EpiUp {
    static constexpr bool PERM = true;
    bf16_t* act; const float* ssq; const f32x4* t64;
    __device__ __forceinline__ void operator()(const f32x4 (&acc)[2][2][4][2], const Unit& u, int wr, int wc, int fr, int fq) const {
        const int pn = u.pn, row0 = u.pm * BM + wr * 64 + fr, tc0 = wc * 32 + 8 * fq; const bool lat = u.pm < 32;
        const int i0 = (wc & 1) * 16 + 4 * fq;
#pragma unroll
        for (int ai = 0; ai < 2; ++ai)
#pragma unroll
            for (int m = 0; m < 4; ++m) { const int row = row0 + ai * HALF + m * 16, t = row & (SEQ - 1);
                const f32x4* sp = (const f32x4*)(ssq + (size_t)row * 16 + (pn >= 3 ? 8 : 0)); const f32x4 s0 = sp[0], s1 = sp[1];
                const float rs = __builtin_amdgcn_rsqf((((s0[0] + s0[1]) + (s0[2] + s0[3])) + ((s1[0] + s1[1]) + (s1[2] + s1[3]))) * (1.0f / 512.0f) + NORM_EPS);
                f32x4 cs0 = (f32x4){1.f, 0.f, 1.f, 0.f}, cs1 = cs0;
                if (pn == 2 && lat) { const f32x4* tp = t64 + ((size_t)t * 32 + i0) / 2; cs0 = tp[0]; cs1 = tp[1]; }
#pragma unroll
                for (int bj = 0; bj < 2; ++bj) { f32x4 v0 = acc[ai][bj][m][0] * rs, v1 = acc[ai][bj][m][1] * rs; u32x4 w;
                    if (pn == 2) {
                        const float a0 = v0[0] * cs0[0] - v0[1] * cs0[1], b0 = v0[1] * cs0[0] + v0[0] * cs0[1];
                        const float a1 = v0[2] * cs0[2] - v0[3] * cs0[3], b1 = v0[3] * cs0[2] + v0[2] * cs0[3];
                        const float a2 = v1[0] * cs1[0] - v1[1] * cs1[1], b2 = v1[1] * cs1[0] + v1[0] * cs1[1];
                        const float a3 = v1[2] * cs1[2] - v1[3] * cs1[3], b3 = v1[3] * cs1[2] + v1[2] * cs1[3];
                        w.x = cvt_pk_bf16(a0, b0); w.y = cvt_pk_bf16(a1, b1); w.z = cvt_pk_bf16(a2, b2); w.w = cvt_pk_bf16(a3, b3);
                    } else { w.x = cvt_pk_bf16(v0[0], v0[1]); w.y = cvt_pk_bf16(v0[2], v0[3]); w.z = cvt_pk_bf16(v1[0], v1[1]); w.w = cvt_pk_bf16(v1[2], v1[3]); }
                    const int c = bj * HALF + tc0; int col;
                    if (pn < 2) col = C_DQ + (pn * 2 + bj) * 192 + tc0;
                    else if (pn == 2) col = C_DQ + (c >> 6) * 192 + 128 + (c & 63);
                    else if (pn < 5) col = C_DK + ((pn - 3) * 2 + bj) * 192 + tc0;
                    else col = C_DV + (pn - 5) * 256 + c;
                    *(u32x4*)(act + (size_t)row * LDACT + col) = w; } }
    }
};
struct EpiMerge {
    static constexpr bool PERM = true;
    bf16_t* gates;
    __device__ __forceinline__ void operator()(const f32x4 (&acc)[2][2][4][2], const Unit& u, int wr, int wc, int fr, int fq) const {
        const int row0 = u.pm * BM + wr * 64 + fr, tc0 = wc * 32 + 8 * fq;
#pragma unroll
        for (int ai = 0; ai < 2; ++ai)
#pragma unroll
            for (int m = 0; m < 4; ++m) { bf16_t* rowp = gates + (size_t)(row0 + ai * HALF + m * 16) * 8192 + u.pn * 256 + tc0;
                u32x4 gv[2];
#pragma unroll
                for (int bj = 0; bj < 2; ++bj) gv[bj] = *(const u32x4*)(rowp + bj * HALF);
#pragma unroll
                for (int bj = 0; bj < 2; ++bj) { const f32x4 v0 = acc[ai][bj][m][0], v1 = acc[ai][bj][m][1]; const u32x4 g = gv[bj]; u32x4 w;
                    w.x = cvt_pk_bf16(v0[0] * bf_lo(g.x), v0[1] * bf_hi(g.x)); w.y = cvt_pk_bf16(v0[2] * bf_lo(g.y), v0[3] * bf_hi(g.y));
                    w.z = cvt_pk_bf16(v1[0] * bf_lo(g.z), v1[1] * bf_hi(g.z)); w.w = cvt_pk_bf16(v1[2] * bf_lo(g.w), v1[3] * bf_hi(g.w));
                    *(u32x4*)(rowp + bj * HALF) = w; } }
    }
};
struct EpiRes {
    static constexpr bool PERM = false;
    const float* x; float* pre; const float* gvec;
    __device__ __forceinline__ void operator()(const f32x4 (&acc)[2][2][4][2], const Unit& u, int wr, int wc, int fr, int fq) const {
        const int row0 = u.pm * BM + wr * 64 + fr, col0 = u.pn * BM + wc * 32 + 4 * fq;
        const float* gp = gvec + (size_t)(u.pm < 32 ? (u.pm >> 3) : 4) * (6 * DM) + col0;
        f32x4 gv[2][2];
#pragma unroll
        for (int bj = 0; bj < 2; ++bj)
#pragma unroll
            for (int n = 0; n < 2; ++n) gv[bj][n] = *(const f32x4*)(gp + bj * HALF + n * 16);
#pragma unroll
        for (int ai = 0; ai < 2; ++ai)
#pragma unroll
            for (int m = 0; m < 4; ++m) { const size_t off = (size_t)(row0 + ai * HALF + m * 16) * DM + col0;
#pragma unroll
                for (int bj = 0; bj < 2; ++bj)
#pragma unroll
                    for (int n = 0; n < 2; ++n) { const f32x4 xv = *(const f32x4*)(x + off + bj * HALF + n * 16);
                        *(f32x4*)(pre + off + bj * HALF + n * 16) = xv * ALPHA + gv[bj][n] * acc[ai][bj][m][n]; }
                asm volatile("" ::: "memory"); }
    }
};
struct EpiSwi {
    static constexpr bool PERM = true;
    bf16_t* fh;
    __device__ __forceinline__ void operator()(const f32x4 (&acc)[2][2][4][2], const Unit& u, int wr, int wc, int fr, int fq) const {
        const int row0 = u.pm * BM + wr * 64 + fr, col0 = u.pn * 128 + wc * 32 + 8 * fq;
#pragma unroll
        for (int ai = 0; ai < 2; ++ai)
#pragma unroll
            for (int m = 0; m < 4; ++m) { const f32x4 g0 = acc[ai][0][m][0], g1 = acc[ai][0][m][1], u0 = acc[ai][1][m][0], u1 = acc[ai][1][m][1]; u32x4 w;
                w.x = cvt_pk_bf16(g0[0] * fast_sigmoid(g0[0]) * u0[0], g0[1] * fast_sigmoid(g0[1]) * u0[1]);
                w.y = cvt_pk_bf16(g0[2] * fast_sigmoid(g0[2]) * u0[2], g0[3] * fast_sigmoid(g0[3]) * u0[3]);
                w.z = cvt_pk_bf16(g1[0] * fast_sigmoid(g1[0]) * u1[0], g1[1] * fast_sigmoid(g1[1]) * u1[1]);
                w.w = cvt_pk_bf16(g1[2] * fast_sigmoid(g1[2]) * u1[2], g1[3] * fast_sigmoid(g1[3]) * u1[3]);
                *(u32x4*)(fh + (size_t)(row0 + ai * HALF + m * 16) * FF + col0) = w; }
    }
};
}

namespace att {
constexpr int NW = 8, QBLK = 32, KVBLK = 64;
constexpr int SHM_V = KVBLK * 128 * 2;
#define SBAR() __builtin_amdgcn_sched_barrier(0)
__device__ __forceinline__ int crow(int r, int hi) { return (r & 3) + 8 * (r >> 2) + 4 * hi; }
__device__ __forceinline__ int v_st(int k, int c) { const int kk = (k & ~0xC) | ((k & 4) << 1) | ((k & 8) >> 1); return ((kk >> 3) * 4 + (c >> 5)) * 512 + ((kk & 7) * 32 + (c & 31)) * 2; }
__device__ __forceinline__ int v_rd_base(int lane) { return ((lane & 3) << 3) | (((lane >> 2) & 3) << 6) | (((lane >> 4) & 1) << 5) | (((lane >> 5) & 1) << 8); }
constexpr int v_rd_off(int d0, int ks, int half) { return d0 * 512 + ks * 4096 + half * 2048; }
template <int OFF> __device__ __forceinline__ s16x4 tr_read(int vb) { s16x4 r; asm volatile("ds_read_b64_tr_b16 %0, %1 offset:%2" : "=&v"(r) : "v"(vb), "i"(OFF) : "memory"); return r; }
template <int D0> __device__ __forceinline__ void pv_one(f32x16& od, int vb, bf16x8 pa0, bf16x8 pa1, bf16x8 pa2, bf16x8 pa3) {
    const s16x4 l0 = tr_read<v_rd_off(D0, 0, 0)>(vb), h0 = tr_read<v_rd_off(D0, 0, 1)>(vb), l1 = tr_read<v_rd_off(D0, 1, 0)>(vb), h1 = tr_read<v_rd_off(D0, 1, 1)>(vb);
    const s16x4 l2 = tr_read<v_rd_off(D0, 2, 0)>(vb), h2 = tr_read<v_rd_off(D0, 2, 1)>(vb), l3 = tr_read<v_rd_off(D0, 3, 0)>(vb), h3 = tr_read<v_rd_off(D0, 3, 1)>(vb);
    asm volatile("s_waitcnt lgkmcnt(0)" ::: "memory"); SBAR();
#define PK(L, H) (bf16x8){L[0], L[1], L[2], L[3], H[0], H[1], H[2], H[3]}
    od = __builtin_amdgcn_mfma_f32_32x32x16_bf16(pa0, PK(l0, h0), od, 0, 0, 0);
    od = __builtin_amdgcn_mfma_f32_32x32x16_bf16(pa1, PK(l1, h1), od, 0, 0, 0);
    od = __builtin_amdgcn_mfma_f32_32x32x16_bf16(pa2, PK(l2, h2), od, 0, 0, 0);
    od = __builtin_amdgcn_mfma_f32_32x32x16_bf16(pa3, PK(l3, h3), od, 0, 0, 0);
#undef PK
}
__device__ __forceinline__ void pv_d0(f32x16* o, int vb, bf16x8 pa0, bf16x8 pa1, bf16x8 pa2, bf16x8 pa3) {
    pv_one<0>(o[0], vb, pa0, pa1, pa2, pa3); pv_one<1>(o[1], vb, pa0, pa1, pa2, pa3); pv_one<2>(o[2], vb, pa0, pa1, pa2, pa3); pv_one<3>(o[3], vb, pa0, pa1, pa2, pa3);
}
template <bool BAND>
__device__ __forceinline__ void partialSM(f32x16& p0, f32x16& p1, float& m_reg, float& mn, float& alpha, const float C, const float thr, bool domask, int dk, int hi) {
    if (BAND) { if (domask) {
#pragma unroll
        for (int r = 0; r < 16; ++r) { const int kk = dk + crow(r, hi); if ((unsigned)(kk + 128) > 256u) p0[r] = -1e30f; if ((unsigned)(kk + 160) > 256u) p1[r] = -1e30f; } } }
    float pmax = p0[0];
#pragma unroll
    for (int r = 1; r < 16; ++r) pmax = fmaxf(pmax, p0[r]);
#pragma unroll
    for (int r = 0; r < 16; ++r) pmax = fmaxf(pmax, p1[r]);
    { auto rr = __builtin_amdgcn_permlane32_swap(__float_as_uint(pmax), __float_as_uint(pmax), false, false); pmax = fmaxf(__uint_as_float(rr[0]), __uint_as_float(rr[1])); }
    if (__builtin_expect(__all(pmax - m_reg <= thr), 1)) { mn = m_reg; alpha = 1.f; }
    else { mn = fmaxf(m_reg, pmax); alpha = __builtin_amdgcn_exp2f((m_reg - mn) * C); m_reg = mn; }
    const float mnC = -mn * C;
#pragma unroll
    for (int r = 0; r < 16; ++r) p0[r] = fmaf(p0[r], C, mnC);
#pragma unroll
    for (int r = 0; r < 16; ++r) p1[r] = fmaf(p1[r], C, mnC);
#pragma unroll
    for (int r = 0; r < 16; ++r) p0[r] = __builtin_amdgcn_exp2f(p0[r]);
}
__device__ __forceinline__ void finishSM(f32x16& p0, f32x16& p1, float alpha, float& l_reg, bf16x8& pa0, bf16x8& pa1, bf16x8& pa2, bf16x8& pa3) {
#pragma unroll
    for (int r = 0; r < 16; ++r) p1[r] = __builtin_amdgcn_exp2f(p1[r]);
    float ps = 0;
#pragma unroll
    for (int r = 0; r < 16; ++r) ps += p0[r];
#pragma unroll
    for (int r = 0; r < 16; ++r) ps += p1[r];
    { auto rr = __builtin_amdgcn_permlane32_swap(__float_as_uint(ps), __float_as_uint(ps), false, false); ps = __uint_as_float(rr[0]) + __uint_as_float(rr[1]); }
    l_reg = l_reg * alpha + ps;
#define PK4(P, BASE, OUT) do { unsigned a0 = cvt_pk_bf16(P[BASE + 0], P[BASE + 1]), a1 = cvt_pk_bf16(P[BASE + 2], P[BASE + 3]);   \
    unsigned b0 = cvt_pk_bf16(P[BASE + 4], P[BASE + 5]), b1 = cvt_pk_bf16(P[BASE + 6], P[BASE + 7]);                              \
    auto r0 = __builtin_amdgcn_permlane32_swap(a0, b0, false, false); auto r1 = __builtin_amdgcn_permlane32_swap(a1, b1, false, false); \
    u32x4 w = {r0[0], r1[0], r0[1], r1[1]}; OUT = *reinterpret_cast<bf16x8*>(&w); } while (0)
    PK4(p0, 0, pa0); PK4(p0, 8, pa1); PK4(p1, 0, pa2); PK4(p1, 8, pa3);
#undef PK4
}
#define KSWZP(row, colB, PITCH) ((row) * (PITCH) + ((colB) ^ (((row) & 7) << 4)))
template <int DQK>
__device__ __forceinline__ void qkt(f32x16& p0, f32x16& p1, const char* Ks, const bf16x8* qr, int r32, int hi) {
    p0 = f32x16{}; p1 = f32x16{};
#pragma unroll
    for (int d0 = 0; d0 < DQK / 16; ++d0) { const int cb = (d0 * 16 + hi * 8) * 2;
        const bf16x8 b0 = *reinterpret_cast<const bf16x8*>(Ks + KSWZP(r32, cb, DQK * 2));
        const bf16x8 b1 = *reinterpret_cast<const bf16x8*>(Ks + KSWZP(32 + r32, cb, DQK * 2));
        p0 = __builtin_amdgcn_mfma_f32_32x32x16_bf16(b0, qr[d0], p0, 0, 0, 0);
        p1 = __builtin_amdgcn_mfma_f32_32x32x16_bf16(b1, qr[d0], p1, 0, 0, 0); }
}
struct UnitArgs {
    const bf16_t* Qb; int ldq;
    const bf16_t* Kb; int ldk;
    const bf16_t* Vb; int ldv;
    int crow0, lrow0, ntc, nt;
    int dpos;
    float sink;
    bf16_t* out; int ldo;
    float* scr;
    float lam, omli; const float* gsub;
    int epi;
};
template <int DQK, bool BAND, bool SINK, int EPI>
__device__ __forceinline__ void attn_unit(const UnitArgs& a, char* lds) {
    constexpr int SDEPTH = (DQK == 192) ? 1 : 2;
    constexpr int NKC = DQK / 64, CH = DQK / 8, SHM_K = KVBLK * DQK * 2;
    constexpr float SCALE = (DQK == 64) ? 0.125f : (DQK == 128 ? 0.088388347648318440f : 0.072168783648703220f);
    constexpr float C = SCALE * 1.4426950408889634f, THRS = 8.0f / SCALE;
    int tid_ = threadIdx.x; asm volatile("" : "+v"(tid_));
    const int tid = tid_, wid = tid >> 6, lane = tid & 63, r32 = lane & 31, hi = lane >> 5;
    char* V_lds = lds; char* K_lds = lds + 2 * SHM_V;
    float* wsf = (float*)(lds + 2 * SHM_V + 2 * SHM_K) + wid * 64; float* li_l = wsf; float* al_l = wsf + 32;
    float m_reg = -1e30f, l_reg = 0; f32x16 o[4] = {}; bf16x8 qr[DQK / 16];
    const bf16_t* Qw = a.Qb + (long)(wid * QBLK + r32) * a.ldq + hi * 8;
#pragma unroll
    for (int d0 = 0; d0 < DQK / 16; ++d0) qr[d0] = *reinterpret_cast<const bf16x8*>(Qw + d0 * 16);
    const int sr = tid >> 4, sc = (tid & 15) * 8, vst0 = v_st(sr, sc), vst1 = v_st(32 + sr, sc);
#define KCOORD(q_, KR, KC) int t__ = tid; if constexpr (NKC == 3) asm volatile("" : "+v"(t__)); const int qq__ = t__ + 512 * (q_); const int KR = qq__ / CH, KC = (qq__ % CH) * 8;
    const int vb0 = (int)(uintptr_t)V_lds + v_rd_base(lane);
    struct { bf16x8 vs0, vs1, ks[NKC]; } sr_[SDEPTH];
    const int dk0 = a.dpos - wid * QBLK - r32;
#define TROW(j) (((j) < a.ntc) ? (a.crow0 + KVBLK * (j)) : (a.lrow0 + KVBLK * ((j) - a.ntc)))
#define SLOAD(i, j) do { const int R0_ = TROW(j); sr_[i].vs0 = *reinterpret_cast<const bf16x8*>(a.Vb + (long)(R0_ + sr) * a.ldv + sc); sr_[i].vs1 = *reinterpret_cast<const bf16x8*>(a.Vb + (long)(R0_ + 32 + sr) * a.ldv + sc); \
    _Pragma("unroll") for (int q_ = 0; q_ < NKC; ++q_) { KCOORD(q_, kr_, kc_) sr_[i].ks[q_] = *reinterpret_cast<const bf16x8*>(a.Kb + (long)(R0_ + kr_) * a.ldk + kc_); } } while (0)
#define SWRITE(b, i) do { *(bf16x8*)(V_lds + (b) * SHM_V + vst0) = sr_[i].vs0; *(bf16x8*)(V_lds + (b) * SHM_V + vst1) = sr_[i].vs1; \
    _Pragma("unroll") for (int q_ = 0; q_ < NKC; ++q_) { KCOORD(q_, kr_, kc_) *(bf16x8*)(K_lds + (b) * SHM_K + KSWZP(kr_, kc_ * 2, DQK * 2)) = sr_[i].ks[q_]; } } while (0)
#define SWAIT() do { if constexpr (SDEPTH == 2) { if constexpr (NKC == 1) asm volatile("s_waitcnt vmcnt(3)" ::: "memory"); else asm volatile("s_waitcnt vmcnt(4)" ::: "memory"); } else asm volatile("s_waitcnt vmcnt(0)" ::: "memory"); } while (0)
#define RESC(al) do { if (__any((al) < 1.f)) { if (hi == 0) al_l[r32] = (al); asm volatile("s_waitcnt lgkmcnt(0)" ::: "memory"); \
    _Pragma("unroll") for (int d = 0; d < 4; ++d) _Pragma("unroll") for (int r = 0; r < 16; ++r) o[d][r] *= al_l[crow(r, hi)]; } } while (0)
#define PSM(P0, P1, MN, AL, j) partialSM<BAND>(P0, P1, m_reg, MN, AL, C, THRS, (j) >= a.ntc, dk0 + KVBLK * ((j) - a.ntc), hi)
    f32x16 pA0, pA1, pB0, pB1; float mnA, mnB, alA, alB; bf16x8 pa0, pa1, pa2, pa3; const int NT = a.nt;
    constexpr int SE = 0, SO = SDEPTH - 1;
    SLOAD(SE, 0); asm volatile("s_waitcnt vmcnt(0)" ::: "memory"); SWRITE(0, SE); __syncthreads();
    qkt<DQK>(pA0, pA1, K_lds, qr, r32, hi); PSM(pA0, pA1, mnA, alA, 0);
    SLOAD(SO, 1); if constexpr (SDEPTH == 2) { if (2 < NT) SLOAD(SE, 2); }
    SWAIT(); SWRITE(1, SO); __syncthreads();
    for (int j = 1; j + 1 < NT; j += 2) {
        SBAR(); qkt<DQK>(pB0, pB1, K_lds + SHM_K, qr, r32, hi);
        finishSM(pA0, pA1, alA, l_reg, pa0, pa1, pa2, pa3); SBAR();
        SLOAD(SO, j + SDEPTH); SBAR();
        pv_d0(o, vb0, pa0, pa1, pa2, pa3); PSM(pB0, pB1, mnB, alB, j);
        __syncthreads(); SWAIT(); SWRITE(0, SE);
        RESC(alB); __syncthreads();
        SBAR(); qkt<DQK>(pA0, pA1, K_lds, qr, r32, hi);
        finishSM(pB0, pB1, alB, l_reg, pa0, pa1, pa2, pa3); SBAR();
        if (SDEPTH == 1 || j + 3 < NT) SLOAD(SE, j + 1 + SDEPTH); SBAR();
        pv_d0(o, vb0 + SHM_V, pa0, pa1, pa2, pa3); PSM(pA0, pA1, mnA, alA, j + 1);
        __syncthreads(); SWAIT(); SWRITE(1, SO);
        RESC(alA); __syncthreads();
    }
    SBAR(); qkt<DQK>(pB0, pB1, K_lds + SHM_K, qr, r32, hi);
    finishSM(pA0, pA1, alA, l_reg, pa0, pa1, pa2, pa3); SBAR();
    pv_d0(o, vb0, pa0, pa1, pa2, pa3); PSM(pB0, pB1, mnB, alB, NT - 1);
    __syncthreads(); RESC(alB);
    finishSM(pB0, pB1, alB, l_reg, pa0, pa1, pa2, pa3); SBAR();
    pv_d0(o, vb0 + SHM_V, pa0, pa1, pa2, pa3);
    if (SINK) l_reg += __builtin_amdgcn_exp2f(a.sink * 1.4426950408889634f - m_reg * C);
    if (hi == 0) li_l[r32] = l_reg; asm volatile("s_waitcnt lgkmcnt(0)" ::: "memory");
    float rli[16];
#pragma unroll
    for (int r = 0; r < 16; ++r) rli[r] = __builtin_amdgcn_rcpf(li_l[crow(r, hi)]);
#define OROW(r) int orow = crow(r, hi); asm volatile("" : "+v"(orow));
    if (EPI == 0) {
        bf16_t* Ow = a.out + (long)(wid * QBLK) * a.ldo + r32;
#pragma unroll
        for (int r = 0; r < 16; ++r) { OROW(r) bf16_t* op = Ow + (long)orow * a.ldo;
#pragma unroll
            for (int d0 = 0; d0 < 4; ++d0) op[d0 * 32] = (bf16_t)(cvt_pk_bf16(o[d0][r] * rli[r], 0.f) & 0xffffu); }
    } else if (EPI == 1) {
        float* Sw = a.scr + (long)(wid * QBLK) * 512 + r32;
#pragma unroll
        for (int r = 0; r < 16; ++r) { OROW(r) float* sp = Sw + (long)orow * 512;
#pragma unroll
            for (int d0 = 0; d0 < 4; ++d0) sp[d0 * 32] = o[d0][r] * rli[r]; }
        asm volatile("s_waitcnt vmcnt(0)" ::: "memory");
    } else {
        const float* Sw = a.scr + (long)(wid * QBLK) * 512 + r32; bf16_t* Ow = a.out + (long)(wid * QBLK) * a.ldo + r32;
#pragma unroll
        for (int r = 0; r < 16; ++r) { OROW(r) const float* sp = Sw + (long)orow * 512; bf16_t* op = Ow + (long)orow * a.ldo; float d[4]; float ss = 0.f;
#pragma unroll
            for (int d0 = 0; d0 < 4; ++d0) { d[d0] = sp[d0 * 32] - a.lam * (o[d0][r] * rli[r]); ss += d[d0] * d[d0]; }
            ss += __shfl_xor(ss, 1); ss += __shfl_xor(ss, 2); ss += __shfl_xor(ss, 4); ss += __shfl_xor(ss, 8); ss += __shfl_xor(ss, 16);
            const float rs = __builtin_amdgcn_rsqf(ss * (1.0f / 128.0f) + NORM_EPS) * a.omli;
#pragma unroll
            for (int d0 = 0; d0 < 4; ++d0) op[d0 * 32] = (bf16_t)(cvt_pk_bf16(d[d0] * rs * a.gsub[d0 * 32 + r32], 0.f) & 0xffffu);
            if ((r & 3) == 3) asm volatile("" ::: "memory"); }
    }
#undef OROW
    __syncthreads();
#undef TROW
#undef KCOORD
#undef SLOAD
#undef SWRITE
#undef SWAIT
#undef RESC
#undef PSM
}
}

#define XB_TMO      128
#define XB_XCNT(j)  (256  + 64 * (j))
#define XB_XSUB(j)  (1280 + 64 * (j))
#define XB_XGEN(j)  (2304 + 64 * (j))
#define XB_TOP      3328
#define XB_TOPGEN   3392
#define XCD_BAR_WORDS 3456
#define XB_SPIN_CAP (1u << 18)
__device__ __forceinline__ unsigned xb_ld(unsigned* p)              { return __hip_atomic_load(p, __ATOMIC_RELAXED, __HIP_MEMORY_SCOPE_AGENT); }
__device__ __forceinline__ unsigned xb_add(unsigned* p, unsigned v) { return __hip_atomic_fetch_add(p, v, __ATOMIC_RELAXED, __HIP_MEMORY_SCOPE_AGENT); }
__device__ __forceinline__ unsigned xb_xcc_id() { return (unsigned)__builtin_amdgcn_s_getreg((3 << 11) | 20) & 0xFu; }
#define XB_SPIN(cond, bar) do { unsigned _sp = 0; while (cond) { __builtin_amdgcn_s_sleep(1); \
    if ((++_sp & 255u) == 0u) { if (xb_ld(&(bar)[XB_TMO])) break; if (_sp > XB_SPIN_CAP) { atomicAdd(&(bar)[XB_TMO], 1u); break; } } } } while (0)
struct XcdBarrier { unsigned* bar; unsigned x; volatile LAS unsigned* st; };
__device__ __forceinline__ XcdBarrier xcd_barrier_post(unsigned* bar, volatile LAS unsigned* st) {
    XcdBarrier b; b.bar = bar; b.x = xb_xcc_id(); b.st = st;
    if (threadIdx.x == 0) (void)xb_add(&bar[XB_XCNT(b.x)], 1u);
    return b;
}
__device__ __forceinline__ void xcd_barrier_complete(unsigned* bar, unsigned x, unsigned& nloc, unsigned& nx) {
    const unsigned G = gridDim.x * gridDim.y * gridDim.z;
    unsigned sum, cnt, mine, sp = 0u;
    for (;;) {
        sum = 0u; cnt = 0u; mine = 0u;
#pragma unroll
        for (unsigned j = 0; j < 16; ++j) { const unsigned c = xb_ld(&bar[XB_XCNT(j)]); sum += c; cnt += (c > 0u) ? 1u : 0u; mine = (j == x) ? c : mine; }
        if (sum == G) break;
        __builtin_amdgcn_s_sleep(1);
        if ((++sp & 255u) == 0u) { if (xb_ld(&bar[XB_TMO])) break; if (sp > XB_SPIN_CAP) { atomicAdd(&bar[XB_TMO], 1u); break; } }
    }
    nloc = mine > 0u ? mine : 1u; nx = cnt > 0u ? cnt : 1u;
}
__device__ __forceinline__ void xcd_barrier(const XcdBarrier& b) {
    asm volatile("s_waitcnt vmcnt(0)" ::: "memory");
    __syncthreads();
    if (threadIdx.x == 0) {
        unsigned* bar = b.bar;
        __builtin_amdgcn_s_waitcnt(0);
        unsigned nloc = b.st[0], nx = b.st[1];
        if (nloc == 0u) { xcd_barrier_complete(bar, b.x, nloc, nx); b.st[0] = nloc; b.st[1] = nx; }
        const unsigned old = xb_add(&bar[XB_XSUB(b.x)], 1u);
        const unsigned gen = old / nloc;
        if (old + 1u == (gen + 1u) * nloc) {
            __builtin_amdgcn_fence(__ATOMIC_RELEASE, "agent");
            asm volatile("s_waitcnt vmcnt(0)" ::: "memory");
            const unsigned og = xb_add(&bar[XB_TOP], 1u);
            const unsigned tg = og / nx;
            if (og + 1u == (tg + 1u) * nx) xb_add(&bar[XB_TOPGEN], 1u);
            else XB_SPIN(xb_ld(&bar[XB_TOPGEN]) == tg, bar);
            __builtin_amdgcn_fence(__ATOMIC_ACQUIRE, "agent");
            xb_add(&bar[XB_XGEN(b.x)], 1u);
            asm volatile("s_waitcnt vmcnt(0)" ::: "memory");
        } else {
            XB_SPIN(xb_ld(&bar[XB_XGEN(b.x)]) == gen, bar);
            __builtin_amdgcn_fence(__ATOMIC_ACQUIRE, "agent");
            asm volatile("s_waitcnt vmcnt(0)" ::: "memory");
        }
    }
    __syncthreads();
}

struct Args {
    const float* in[23];
    float* out; unsigned char* ws;
    int ph_lo, ph_hi;
};
typedef const __attribute__((address_space(4))) Args* ArgsP;
enum { I_X = 0, I_C, I_CTX, I_CCTX, I_WADA, I_BADA, I_WIN, I_AQKN, I_BSINK, I_CLAM, I_CSUBLN, I_MQN, I_MWQ, I_MKVN, I_MWKV, I_WBR, I_WOUT, I_LMG, I_LMB, I_WFI, I_WFO, I_LFG, I_LFB };
constexpr int NPH_LAYER = 10, NPH_PRO = 2, NPH_TOTAL = NPH_PRO + DEPTH * NPH_LAYER;

template <class SrcFn>
__device__ __forceinline__ void cvt_item(const float* W, int K, int Nsrc, bf16_t* WT, const float* kscale, LAS float* scr, int kb, int nb, int lane, SrcFn srcf) {
    const int k0 = 64 * kb, n0 = 32 * nb; const int sc = srcf(n0 + (lane & 31));
    float v[32];
    const float* wp = W + (size_t)(k0 + (lane >> 5)) * Nsrc + sc;
#pragma unroll
    for (int i = 0; i < 32; ++i) v[i] = wp[(size_t)(2 * i) * Nsrc];
    if (kscale) {
#pragma unroll
        for (int i = 0; i < 32; ++i) v[i] *= kscale[k0 + 2 * i + (lane >> 5)]; }
#pragma unroll
    for (int i = 0; i < 32; ++i) scr[(2 * i + (lane >> 5)) * 33 + (lane & 31)] = v[i];
    asm volatile("s_waitcnt lgkmcnt(0)" ::: "memory");
    const int c = lane & 7;
#pragma unroll
    for (int j = 0; j < 4; ++j) { const int n = (lane >> 3) + 8 * j; const LAS float* s = scr + (8 * c) * 33 + n;
        u32x4 o; o.x = cvt_pk_bf16(s[0 * 33], s[1 * 33]); o.y = cvt_pk_bf16(s[2 * 33], s[3 * 33]); o.z = cvt_pk_bf16(s[4 * 33], s[5 * 33]); o.w = cvt_pk_bf16(s[6 * 33], s[7 * 33]);
        *(u32x4*)(WT + (size_t)(n0 + n) * K + k0 + 8 * c) = o; }
    asm volatile("s_waitcnt lgkmcnt(0)" ::: "memory");
}
constexpr int IT_IN = (DM / 64) * (NIN / 32), IT_QUP = (512 / 64) * (768 / 32), IT_KVUP = (512 / 64) * (1024 / 32), IT_BR = 4 * (512 / 64) * (DM / 32), IT_OUT = (DM / 64) * (DM / 32),
              IT_FI = (DM / 64) * (2 * FF / 32), IT_FO = (FF / 64) * (DM / 32), IT_LAYER = IT_IN + IT_QUP + IT_KVUP + IT_BR + IT_OUT + IT_FI + IT_FO;
__device__ __forceinline__ void convert_weights_item(ArgsP Ap, int it, LAS float* scr, int lane) {
    const auto& A = *Ap;
    const int l = it / IT_LAYER; int r = it % IT_LAYER;
    unsigned char* wl = A.ws + WS_W + (size_t)l * WL_SIZE;
    if (r < IT_IN) { const int nblk = NIN / 32; cvt_item(A.in[I_WIN] + (size_t)l * DM * NIN_SRC, DM, NIN_SRC, (bf16_t*)(wl + WL_IN), nullptr, scr, r / nblk, r % nblk, lane, [](int n) { return win_src(n); }); return; } r -= IT_IN;
    if (r < IT_QUP) { const int nblk = 768 / 32; cvt_item(A.in[I_MWQ] + (size_t)l * 512 * 768, 512, 768, (bf16_t*)(wl + WL_UP), A.in[I_MQN] + l * 512, scr, r / nblk, r % nblk, lane,
        [](int n) { return n < 512 ? (n >> 7) * 192 + (n & 127) : ((n - 512) >> 6) * 192 + 128 + L64((n - 512) & 63); }); return; } r -= IT_QUP;
    if (r < IT_KVUP) { const int nblk = 1024 / 32; cvt_item(A.in[I_MWKV] + (size_t)l * 512 * 1024, 512, 1024, (bf16_t*)(wl + WL_UP) + (size_t)768 * 512, A.in[I_MKVN] + l * 512, scr, r / nblk, r % nblk, lane,
        [](int n) { return n < 512 ? (n >> 7) * 256 + (n & 127) : ((n - 512) >> 7) * 256 + 128 + ((n - 512) & 127); }); return; } r -= IT_KVUP;
    if (r < IT_BR) { const int per = IT_BR / 4, m = r / per, rr = r % per, nblk = DM / 32;
        cvt_item(A.in[I_WBR] + ((size_t)l * 4 + m) * 512 * DM, 512, DM, (bf16_t*)(wl + WL_BR) + (size_t)m * DM * 512, nullptr, scr, rr / nblk, rr % nblk, lane, [](int n) { return n; }); return; } r -= IT_BR;
    if (r < IT_OUT) { const int nblk = DM / 32; cvt_item(A.in[I_WOUT] + (size_t)l * DM * DM, DM, DM, (bf16_t*)(wl + WL_OUT), nullptr, scr, r / nblk, r % nblk, lane, [](int n) { return n; }); return; } r -= IT_OUT;
    if (r < IT_FI) { const int nblk = 2 * FF / 32; cvt_item(A.in[I_WFI] + (size_t)l * DM * 2 * FF, DM, 2 * FF, (bf16_t*)(wl + WL_FI), nullptr, scr, r / nblk, r % nblk, lane,
        [](int n) { const int t = n >> 8, w = n & 255; return w < 128 ? t * 128 + w : FF + t * 128 + (w - 128); }); return; } r -= IT_FI;
    { const int nblk = DM / 32; cvt_item(A.in[I_WFO] + (size_t)l * FF * DM, FF, DM, (bf16_t*)(wl + WL_FO), nullptr, scr, r / nblk, r % nblk, lane, [](int n) { return n; }); }
}
__device__ __forceinline__ void ada_unit(ArgsP Ap, int unit, LAS unsigned char* lds, int tid) {
    const auto& A = *Ap;
    LAS float* sl = (LAS float*)lds;
    LAS float* red = (LAS float*)(lds + 40960);
    const int l = unit / 48, cb = unit % 48, wid = tid >> 6, lane = tid & 63;
    for (int i = tid; i < 5 * DM; i += 512) { const int r = i / DM, k = i % DM; const float v = r < 4 ? A.in[I_C][r * DM + k] : A.in[I_CCTX][k]; sl[i] = v / (1.0f + __expf(-v)); }
    __syncthreads();
    const float* W = A.in[I_WADA] + (size_t)l * DM * (6 * DM) + cb * 256 + lane * 4;
    f32x4 acc[5];
#pragma unroll
    for (int r = 0; r < 5; ++r) acc[r] = (f32x4){0.f, 0.f, 0.f, 0.f};
    const int kbeg = wid * 256;
    for (int k = kbeg; k < kbeg + 256; k += 8) {
        f32x4 w[8];
#pragma unroll
        for (int j = 0; j < 8; ++j) w[j] = *(const f32x4*)(W + (size_t)(k + j) * (6 * DM));
#pragma unroll
        for (int j = 0; j < 8; ++j)
#pragma unroll
            for (int r = 0; r < 5; ++r) { const float s = sl[r * DM + k + j]; acc[r] += w[j] * s; }
    }
#pragma unroll
    for (int r = 0; r < 5; ++r) *(LAS f32x4*)(red + (wid * 5 + r) * 256 + lane * 4) = acc[r];
    __syncthreads();
    for (int i = tid; i < 5 * 256; i += 512) { const int r = i / 256, c = i % 256; float s = 0.f;
#pragma unroll
        for (int w = 0; w < 8; ++w) s += red[(w * 5 + r) * 256 + c];
        const int col = cb * 256 + c;
        ((float*)(A.ws + WS_ADA))[((size_t)l * 5 + r) * (6 * DM) + col] = s + A.in[I_BADA][(size_t)l * 6 * DM + col]; }
    __syncthreads();
}
__device__ __forceinline__ void ln_row(const float* src, float* xdst, bf16_t* hdst, const float* gam, const float* bet, const float* sc, const float* sh, int lane_) {
    int lane = lane_; asm volatile("" : "+v"(lane));
    f32x4 v[8]; float s = 0.f;
#pragma unroll
    for (int j = 0; j < 8; ++j) { v[j] = *(const f32x4*)(src + 256 * j + 4 * lane); s += (v[j][0] + v[j][1]) + (v[j][2] + v[j][3]); }
    const float mean = wave_sum(s) * (1.0f / DM); float q = 0.f;
#pragma unroll
    for (int j = 0; j < 8; ++j) { v[j] = v[j] - mean; q += (v[j][0] * v[j][0] + v[j][1] * v[j][1]) + (v[j][2] * v[j][2] + v[j][3] * v[j][3]); }
    const float rstd = 1.0f / sqrtf(wave_sum(q) * (1.0f / DM) + NORM_EPS);
#pragma unroll
    for (int j = 0; j < 8; ++j) { const int c = 256 * j + 4 * lane; f32x4 y = v[j] * rstd;
        if (gam) y = y * *(const f32x4*)(gam + c) + *(const f32x4*)(bet + c);
        *(f32x4*)(xdst + c) = y;
        if (hdst) { const f32x4 h = y * (*(const f32x4*)(sc + c) + 1.0f) + *(const f32x4*)(sh + c); u32x2 w; w.x = cvt_pk_bf16(h[0], h[1]); w.y = cvt_pk_bf16(h[2], h[3]); *(u32x2*)(hdst + c) = w; } }
}

__device__ __forceinline__ ArgsP args_ptr() { ArgsP p = (ArgsP)__builtin_amdgcn_kernarg_segment_ptr(); asm volatile("" : "+s"(p)); return p; }
#define WSP(T, off) ((T*)(ws + (off)))
#define PH_ENTER() ArgsP ap = args_ptr(); unsigned char* ws = ap->ws; int Gp = (int)gridDim.x, bxp = (int)blockIdx.x; asm volatile("" : "+s"(Gp), "+s"(bxp)); (void)Gp; (void)bxp


#define TAIL_CONVERT(nunits, i0, i1) do { if (l + 1 < DEPTH) { const int rem_ = (nunits) % Gp; if (rem_ != 0 && bxp >= rem_) { const int nw_ = (Gp - rem_) * 8, w_ = (bxp - rem_) * 8 + wid; \
        LAS float* scr_ = (LAS float*)(lds + wid * 16384); int ln_ = threadIdx.x & 63; asm volatile("" : "+v"(ln_)); \
        for (int it_ = (i0) + w_; it_ < (i1); it_ += nw_) convert_weights_item(ap, (l + 1) * IT_LAYER + it_, scr_, ln_); } } } while (0)
__global__ void __launch_bounds__(512, 2) mk_fwd(Args Aarg) {
    extern __shared__ __attribute__((aligned(16))) unsigned char lds_raw[];
    LAS unsigned char* lds = (LAS unsigned char*)lds_raw;
    const int tid = threadIdx.x, lane = tid & 63, wid = __builtin_amdgcn_readfirstlane(tid >> 6);
    const int G = gridDim.x, bx = blockIdx.x;
    volatile LAS unsigned* MISC = (volatile LAS unsigned*)(lds + LDSCTL_OFF);
    for (int u = tid; u < 256; u += 512) ((LAS unsigned*)(lds + LDSCTL_OFF))[u] = 0u;
    __syncthreads();
    XcdBarrier bar; bar.bar = nullptr; bar.x = 0; bar.st = nullptr;
    if (MK_N_LAUNCHES == 1) bar = xcd_barrier_post((unsigned*)(Aarg.ws + WS_CTL) + CW_BAR, MISC + 8);
    const int lo = Aarg.ph_lo, hi = Aarg.ph_hi;
#ifndef PHMASK
#define PHMASK 0xFFFFFFFFu
#endif
#define IN(k) (lo <= (k) && (k) < hi)
#define PHON(b) ((PHMASK >> (b)) & 1u)
#ifndef PROBE_DUP
#define PROBE_DUP 0u
#endif
#define NREP(b) (1 + (int)((PROBE_DUP >> (b)) & 1u))
#define SEAM(k) do { if (MK_N_LAUNCHES == 1 && (k) + 1 < hi) xcd_barrier(bar); } while (0)
    const int gw = bx * 8 + wid, NGW = G * 8;

    if (PHON(0) && IN(0)) {
_Pragma("unroll") for (int rep_ = 0; rep_ < NREP(0); ++rep_) {
        PH_ENTER();
        for (int u = bx; u < DEPTH * 48; u += G) ada_unit(ap, u, lds, tid);
        for (int i = bx * 512 + tid; i < SEQ * 96; i += G * 512) {
            const int t = i / 96, e = i % 96;
            if (e < 64) { const int ax = e >> 5, f = e & 31; const float pos = ax ? (float)(t & 63) : (float)(t >> 6); const float ang = pos * powf(10000.0f, -(float)f / 32.0f);
                WSP(f32x2, WS_T128)[(size_t)t * 64 + e] = (f32x2){cosf(ang), sinf(ang)}; }
            else { const int e2 = e - 64, ax = e2 >> 4, f = e2 & 15; const float pos = ax ? (float)(t & 63) : (float)(t >> 6); const float ang = pos * powf(10000.0f, -(float)f / 16.0f);
                WSP(f32x2, WS_T64)[(size_t)t * 32 + e2] = (f32x2){cosf(ang), sinf(ang)}; }
        }
        if (bx == 0 && wid < DEPTH) { const float* cl = ap->in[I_CLAM] + wid * 256; const float s1 = wave_sum(cl[lane] * cl[64 + lane]), s2 = wave_sum(cl[128 + lane] * cl[192 + lane]);
            if (lane == 0) WSP(float, WS_LAM)[wid] = expf(s1) - expf(s2) + (0.8f - 0.6f * expf(-0.3f * (float)wid)); }
        { LAS float* scr = (LAS float*)(lds + wid * 16384);
          for (int it = gw; it < IT_LAYER; it += NGW) convert_weights_item(ap, it, scr, lane); }
        __syncthreads();
        }
            SEAM(0);
    }
    if (PHON(1) && IN(1)) {
        PH_ENTER(); const float* xin = ap->in[I_X]; const float* cin = ap->in[I_CTX];
        for (int row = gw; row < MT; row += NGW) {
            const float* src = row < ML ? xin + (size_t)row * DM : cin + (size_t)(row - ML) * DM;
            const float* ad = WSP(float, WS_ADA) + (size_t)(row < ML ? (row >> 11) : 4) * (6 * DM);
            ln_row(src, WSP(float, WS_X) + (size_t)row * DM, WSP(bf16_t, WS_HB) + (size_t)row * DM, nullptr, nullptr, ad + 1 * DM, ad + 0 * DM, lane);
        }
        SEAM(1);
    }
    for (int l = 0; l < DEPTH; ++l) {
        const int p0 = NPH_PRO + l * NPH_LAYER;
        if (hi <= p0 || lo >= p0 + NPH_LAYER) continue;
        const bool lastl = (l == DEPTH - 1);
        const int nMpost = lastl ? 32 : 36;
        if (PHON(2) && IN(p0 + 0)) {
_Pragma("unroll") for (int rep_ = 0; rep_ < NREP(2); ++rep_) {
            PH_ENTER();
            pg8::Gemm g{WSP(bf16_t, WS_HB), WSP(const bf16_t, WS_W + (size_t)l * WL_SIZE + WL_IN), DM, DM, DM}; pg8::Order<0> S; S.init(36, NIN / 256, Gp, bxp, DM, DM);
            pg8::EpiIn E{WSP(bf16_t, WS_ACT), WSP(bf16_t, WS_G), WSP(bf16_t, WS_DQKV), WSP(float, WS_SSQ), WSP(const f32x4, WS_T128), WSP(const f32x4, WS_T64), ap->in[I_AQKN] + l * 256, (LAS float*)(lds + XCH_OFF)};
            pg8::gemm_phase(lds, g, S, E);
            TAIL_CONVERT(36 * (NIN / 256), 0, IT_LAYER / 2);
            }
            SEAM(p0 + 0);
        }
        if (PHON(3) && IN(p0 + 1)) {
_Pragma("unroll") for (int rep_ = 0; rep_ < NREP(3); ++rep_) {
            PH_ENTER();
            pg8::Gemm g{WSP(bf16_t, WS_DQKV), WSP(const bf16_t, WS_W + (size_t)l * WL_SIZE + WL_UP), 512, 512, 512}; pg8::Order<2> S; S.init(36, 7, Gp, bxp, 512, 512);
            pg8::EpiUp E{WSP(bf16_t, WS_ACT), WSP(float, WS_SSQ), WSP(const f32x4, WS_T64)};
            pg8::gemm_phase(lds, g, S, E);
            }
            SEAM(p0 + 1);
        }
        if (PHON(4) && IN(p0 + 2)) {
_Pragma("unroll") for (int rep_ = 0; rep_ < NREP(4); ++rep_) {
            PH_ENTER();
            unsigned* qhead = WSP(unsigned, WS_CTL) + CW_QUEUE + 64 * l + 32 * rep_;
            bf16_t* ACT = WSP(bf16_t, WS_ACT); bf16_t* OUTS = WSP(bf16_t, WS_OUTS);
            const float lam = WSP(float, WS_LAM)[l], omli = 1.0f - (0.8f - 0.6f * expf(-0.3f * (float)l));
#define ATT_FETCH() do { if (tid == 0) MISC[16] = __hip_atomic_fetch_add(qhead, 1u, __ATOMIC_RELAXED, __HIP_MEMORY_SCOPE_AGENT); __syncthreads(); L = (int)MISC[16]; __syncthreads(); } while (0)
#define ATT_DECODE(base) const int r_ = L - (base); const bool isctx = r_ >= 128; const int b = isctx ? ((r_ - 128) >> 2) : (r_ >> 5), h = isctx ? (r_ & 3) : ((r_ >> 3) & 3), qb = isctx ? 0 : (r_ & 7); \
                const int qrow0 = isctx ? (ML + b * CTXL) : (b * SEQ + qb * 256); att::UnitArgs ua; ua.crow0 = ML + b * CTXL; ua.ntc = 4; ua.lrow0 = b * SEQ; ua.nt = isctx ? 4 : 36; ua.dpos = 0; ua.sink = 0.f; \
                ua.ldo = DM; ua.scr = WSP(float, WS_O1) + (size_t)qrow0 * 512 + h * 128; ua.lam = lam; ua.omli = omli; ua.gsub = ap->in[I_CSUBLN] + l * 128; ua.ldq = LDACT; ua.ldk = LDACT; ua.ldv = LDACT;
            int L; ATT_FETCH();
#ifndef ATTMASK
#define ATTMASK 15
#endif
            while ((ATTMASK & 1) && L < 144) {
                if (!(lastl && L >= 128)) { ATT_DECODE(0)
                    ua.Vb = ACT + C_CV + h * 128; ua.out = OUTS + (size_t)qrow0 * DM + 1024 + h * 128;
                    ua.Qb = ACT + (size_t)qrow0 * LDACT + C_CQ + h * 128; ua.Kb = ACT + C_CK + h * 128;
                    att::attn_unit<64, false, false, 1>(ua, (char*)lds_raw);
                    ua.Qb += 64; ua.Kb += 64;
                    att::attn_unit<64, false, false, 2>(ua, (char*)lds_raw); }
                ATT_FETCH();
            }
            while ((ATTMASK & 2) && L < 288) {
                if (!(lastl && L >= 272)) { ATT_DECODE(144)
                    ua.Qb = ACT + (size_t)qrow0 * LDACT + C_DQ + h * 192; ua.Kb = ACT + C_DK + h * 192; ua.Vb = ACT + C_DV + h * 128; ua.out = OUTS + (size_t)qrow0 * DM + 1536 + h * 128;
                    att::attn_unit<192, false, false, 0>(ua, (char*)lds_raw); }
                ATT_FETCH();
            }
            while ((ATTMASK & 4) && L < 432) {
                if (!(lastl && L >= 416)) { ATT_DECODE(288)
                    ua.Qb = ACT + (size_t)qrow0 * LDACT + C_AQ + h * 128; ua.Kb = ACT + C_AK + (h >> 1) * 128; ua.Vb = ACT + C_AV + (h >> 1) * 128; ua.out = OUTS + (size_t)qrow0 * DM + 0 + h * 128;
                    att::attn_unit<128, false, false, 0>(ua, (char*)lds_raw); }
                ATT_FETCH();
            }
            while ((ATTMASK & 8) && L < 576) {
                if (!(lastl && L >= 560)) { ATT_DECODE(432)
                    ua.Qb = ACT + (size_t)qrow0 * LDACT + C_BQ + h * 128; ua.Kb = ACT + C_BK + (h >> 1) * 128; ua.Vb = ACT + C_BV + (h >> 1) * 128; ua.out = OUTS + (size_t)qrow0 * DM + 512 + h * 128;
                    ua.sink = ap->in[I_BSINK][l * 4 + h];
                    if (!isctx) { const int t0 = (4 * qb - 2) < 0 ? 0 : (4 * qb - 2), t1 = (4 * qb + 5) > 31 ? 31 : (4 * qb + 5);
                        ua.lrow0 = b * SEQ + 64 * t0; ua.nt = 4 + (t1 - t0 + 1); ua.dpos = 64 * t0 - 256 * qb; }
                    att::attn_unit<128, true, true, 0>(ua, (char*)lds_raw); }
                ATT_FETCH();
            }
#undef ATT_FETCH
#undef ATT_DECODE
            }
            SEAM(p0 + 2);
        }
        if (PHON(5) && IN(p0 + 3)) {
            PH_ENTER();
            pg8::Gemm g{WSP(bf16_t, WS_OUTS), WSP(const bf16_t, WS_W + (size_t)l * WL_SIZE + WL_BR), 512, DM, 512}; pg8::Order<1> S; S.init(nMpost, 32, Gp, bxp, DM, 512);
            pg8::EpiMerge E{WSP(bf16_t, WS_G)};
            pg8::gemm_phase(lds, g, S, E);
            SEAM(p0 + 3);
        }
        if (PHON(6) && IN(p0 + 4)) {
_Pragma("unroll") for (int rep_ = 0; rep_ < NREP(6); ++rep_) {
            PH_ENTER(); const bf16_t* GT = WSP(bf16_t, WS_G); bf16_t* Y = WSP(bf16_t, WS_Y);
            const int nchunk = nMpost * 256 * (DM / 8); int t_ = threadIdx.x; asm volatile("" : "+v"(t_));
            for (int i = bx * 512 + t_; i < nchunk; i += G * 512) { const int row = i >> 8, c8 = (i & 255) * 8; const bf16_t* zp = GT + (size_t)row * 8192 + c8;
                const u32x4 z0 = *(const u32x4*)zp, z1 = *(const u32x4*)(zp + 2048), z2 = *(const u32x4*)(zp + 4096), z3 = *(const u32x4*)(zp + 6144); u32x4 w;
#define S4(f) ((bf_lo(z0.f) + bf_lo(z1.f)) + (bf_lo(z2.f) + bf_lo(z3.f))), ((bf_hi(z0.f) + bf_hi(z1.f)) + (bf_hi(z2.f) + bf_hi(z3.f)))
                w.x = cvt_pk_bf16(S4(x)); w.y = cvt_pk_bf16(S4(y)); w.z = cvt_pk_bf16(S4(z)); w.w = cvt_pk_bf16(S4(w));
#undef S4
                *(u32x4*)(Y + (size_t)row * DM + c8) = w; }
            }
            SEAM(p0 + 4);
        }
        if (PHON(7) && IN(p0 + 5)) {
_Pragma("unroll") for (int rep_ = 0; rep_ < NREP(7); ++rep_) {
            PH_ENTER();
            pg8::Gemm g{WSP(bf16_t, WS_Y), WSP(const bf16_t, WS_W + (size_t)l * WL_SIZE + WL_OUT), DM, DM, DM}; pg8::Order<0> S; S.init(nMpost, 8, Gp, bxp, DM, DM);
            pg8::EpiRes E{WSP(float, WS_X), WSP(float, WS_PRE), WSP(float, WS_ADA) + (size_t)l * 5 * (6 * DM) + 2 * DM};
            pg8::gemm_phase(lds, g, S, E);
            }
            SEAM(p0 + 5);
        }
        if (PHON(8) && IN(p0 + 6)) {
_Pragma("unroll") for (int rep_ = 0; rep_ < NREP(8); ++rep_) {
            PH_ENTER(); const float* gam = ap->in[I_LMG] + l * DM; const float* bet = ap->in[I_LMB] + l * DM;
            for (int row = gw; row < nMpost * 256; row += NGW) { const float* ad = WSP(float, WS_ADA) + (size_t)l * 5 * (6 * DM) + (size_t)(row < ML ? (row >> 11) : 4) * (6 * DM);
                ln_row(WSP(float, WS_PRE) + (size_t)row * DM, WSP(float, WS_X) + (size_t)row * DM, WSP(bf16_t, WS_HB) + (size_t)row * DM, gam, bet, ad + 4 * DM, ad + 3 * DM, lane); }
            }
            SEAM(p0 + 6);
        }
        if (PHON(9) && IN(p0 + 7)) {
_Pragma("unroll") for (int rep_ = 0; rep_ < NREP(9); ++rep_) {
            PH_ENTER();
            pg8::Gemm g{WSP(bf16_t, WS_HB), WSP(const bf16_t, WS_W + (size_t)l * WL_SIZE + WL_FI), DM, DM, DM}; pg8::Order<0> S; S.init(nMpost, 2 * FF / 256, Gp, bxp, DM, DM);
            pg8::EpiSwi E{WSP(bf16_t, WS_FH)};
            pg8::gemm_phase(lds, g, S, E);
            TAIL_CONVERT(nMpost * (2 * FF / 256), IT_LAYER / 2, IT_LAYER);
            }
            SEAM(p0 + 7);
        }
        if (PHON(10) && IN(p0 + 8)) {
_Pragma("unroll") for (int rep_ = 0; rep_ < NREP(10); ++rep_) {
            PH_ENTER();
            pg8::Gemm g{WSP(bf16_t, WS_FH), WSP(const bf16_t, WS_W + (size_t)l * WL_SIZE + WL_FO), FF, FF, FF}; pg8::Order<0> S; S.init(nMpost, 8, Gp, bxp, FF, FF);
            pg8::EpiRes E{WSP(float, WS_X), WSP(float, WS_PRE), WSP(float, WS_ADA) + (size_t)l * 5 * (6 * DM) + 5 * DM};
            pg8::gemm_phase(lds, g, S, E);
            }
            SEAM(p0 + 8);
        }
        if (PHON(11) && IN(p0 + 9)) {
_Pragma("unroll") for (int rep_ = 0; rep_ < NREP(11); ++rep_) {
            PH_ENTER(); const float* gam = ap->in[I_LFG] + l * DM; const float* bet = ap->in[I_LFB] + l * DM;
            float* xo = lastl ? ap->out : WSP(float, WS_X);
            const float* adaN = WSP(float, WS_ADA) + (size_t)(lastl ? l : l + 1) * 5 * (6 * DM);
            for (int row = gw; row < nMpost * 256; row += NGW) { const float* ad = adaN + (size_t)(row < ML ? (row >> 11) : 4) * (6 * DM);
                ln_row(WSP(float, WS_PRE) + (size_t)row * DM, xo + (size_t)row * DM, lastl ? nullptr : WSP(bf16_t, WS_HB) + (size_t)row * DM, gam, bet, ad + 1 * DM, ad + 0 * DM, lane); }
            }
            SEAM(p0 + 9);
        }
    }
#undef IN
#undef SEAM
}


#ifndef MK_DIAG
#define MK_DIAG 0
#endif
#if MK_DIAG
struct Reg { size_t off, bytes; };
__global__ void k_cksum(const unsigned char* ws, size_t off, size_t bytes, unsigned long long* slot) {
    const uint4* p = (const uint4*)(ws + off); const size_t n = bytes / 16; unsigned long long s = 0;
    for (size_t i = (size_t)blockIdx.x * blockDim.x + threadIdx.x; i < n; i += (size_t)gridDim.x * blockDim.x) { const uint4 v = p[i]; s += (unsigned long long)v.x * 3u + (unsigned long long)v.y * 5u + (unsigned long long)v.z * 7u + (unsigned long long)v.w * 11u + (i & 0xffff); }
    for (int o = 32; o >= 1; o >>= 1) s += __shfl_xor(s, o);
    if ((threadIdx.x & 63) == 0) atomicAdd(slot, s);
}
__global__ void k_diag_out(const unsigned long long* tab, int nph, float* out, int n) {
    int code = 0; for (int p = nph - 1; p >= 0; --p) if (tab[p] != tab[64 + p]) code = p + 1;
    for (int i = blockIdx.x * blockDim.x + threadIdx.x; i < n; i += gridDim.x * blockDim.x) out[i] = (i == 0) ? 1.0e6f * (float)code : 0.0f;
}
#endif
extern "C" void kernel_launch(void* const* d_in, const int* in_sizes, int n_in, void* d_out, int out_size, void* d_ws, size_t ws_size, hipStream_t stream) {
    static int grid = 0;
    if (grid == 0) {
        if (n_in != 23 || out_size != ML * DM || ws_size < WS_END) { fprintf(stderr, "kernel_launch: shape mismatch (n_in %d out %d ws %zu need %zu)\n", n_in, out_size, ws_size, (size_t)WS_END); grid = -1; return; }
        int dev = 0, cus = 0, per_cu = 0;
        if (hipGetDevice(&dev) != hipSuccess || hipDeviceGetAttribute(&cus, hipDeviceAttributeMultiprocessorCount, dev) != hipSuccess) { grid = -1; return; }
        if (hipFuncSetAttribute((const void*)mk_fwd, hipFuncAttributeMaxDynamicSharedMemorySize, LDS_BYTES) != hipSuccess) { fprintf(stderr, "kernel_launch: hipFuncSetAttribute failed\n"); grid = -1; return; }
        if (hipOccupancyMaxActiveBlocksPerMultiprocessor(&per_cu, (const void*)mk_fwd, 512, LDS_BYTES) != hipSuccess || per_cu < 1) { fprintf(stderr, "kernel_launch: occupancy query says %d\n", per_cu); }
        (void)hipGetLastError();
        grid = cus;
    }
    if (grid < 0) return;
    if (hipMemsetAsync((char*)d_ws + WS_CTL, 0, CTL_ZERO_BYTES, stream) != hipSuccess) return;
    Args a{};
    for (int i = 0; i < 23; ++i) a.in[i] = (const float*)d_in[i];
    a.out = (float*)d_out; a.ws = (unsigned char*)d_ws;
#if MK_DIAG
    {   unsigned long long* tab = (unsigned long long*)((char*)d_ws + WS_CTL + 512 * 1024);
        const int NP = DIAG_NP;
        for (int run = 0; run < 2; ++run) for (int p = 0; p < NP; ++p) {
            if (run == 1 && p == 0) hipMemsetAsync((char*)d_ws + WS_CTL, 0, 256 * 1024, stream);
            a.ph_lo = p; a.ph_hi = p + 1; hipLaunchKernelGGL(mk_fwd, dim3(grid), dim3(512), LDS_BYTES, stream, a);
            Reg regs[4]; int nr = 0; const int q = (p - 2) % 10;
            if (p == 0) { regs[nr++] = {WS_ADA, (size_t)DEPTH * 5 * 6 * DM * 4}; regs[nr++] = {WS_T128, 3 * MiB / 2}; regs[nr++] = {WS_LAM, 16}; regs[nr++] = {WS_W, DEPTH * WL_SIZE}; }
            else if (p == 1 || q == 6 || q == 9) { regs[nr++] = {WS_X, SZ_F32ROWS}; regs[nr++] = {WS_HB, SZ_BF16ROWS}; }
            else if (q == 0) { regs[nr++] = {WS_G, (size_t)MT * 8192 * 2}; regs[nr++] = {WS_DQKV, (size_t)2 * MT * 512 * 2}; regs[nr++] = {WS_SSQ, (size_t)MT * 16 * 4}; }
            else if (q == 1) { regs[nr++] = {WS_ACT, (size_t)MT * LDACT * 2}; }
            else if (q == 2) { regs[nr++] = {WS_OUTS, SZ_BF16ROWS}; regs[nr++] = {WS_O1, (size_t)MT * 512 * 4}; }
            else if (q == 3) { regs[nr++] = {WS_G, (size_t)MT * 8192 * 2}; }
            else if (q == 4) { regs[nr++] = {WS_Y, SZ_BF16ROWS}; }
            else if (q == 5 || q == 8) { regs[nr++] = {WS_PRE, SZ_F32ROWS}; }
            else if (q == 7) { regs[nr++] = {WS_FH, (size_t)MT * FF * 2}; }
            for (int r = 0; r < nr; ++r) hipLaunchKernelGGL(k_cksum, dim3(1024), dim3(256), 0, stream, (const unsigned char*)d_ws, regs[r].off, regs[r].bytes, tab + run * 64 + p);
        }
        hipLaunchKernelGGL(k_diag_out, dim3(1024), dim3(256), 0, stream, (const unsigned long long*)tab, NP, (float*)d_out, out_size);
        return;
    }
#endif
    if (MK_N_LAUNCHES == 1) { a.ph_lo = 0; a.ph_hi = NPH_TOTAL; hipLaunchKernelGGL(mk_fwd, dim3(grid), dim3(512), LDS_BYTES, stream, a); }
    else for (int p = 0; p < NPH_TOTAL; ++p) { a.ph_lo = p; a.ph_hi = p + 1; hipLaunchKernelGGL(mk_fwd, dim3(grid), dim3(512), LDS_BYTES, stream, a); }
    const hipError_t le = hipPeekAtLastError();
    if (le != hipSuccess) fprintf(stderr, "kernel_launch: launch failed: %s\n", hipGetErrorName(le));
}
```

```cpp
#include <hip/hip_runtime.h>
#include <cstdio>
#include <cstdint>

#ifndef MK_N_LAUNCHES
#define MK_N_LAUNCHES 1
#endif

#define LAS __attribute__((address_space(3)))
#define GAS __attribute__((address_space(1)))
typedef unsigned short bf16_t;
typedef short bf16x8 __attribute__((ext_vector_type(8)));
typedef short s16x4 __attribute__((ext_vector_type(4)));
typedef float f32x2 __attribute__((ext_vector_type(2)));
typedef float f32x4 __attribute__((ext_vector_type(4)));
typedef float f32x16 __attribute__((ext_vector_type(16)));
typedef unsigned u32x2 __attribute__((ext_vector_type(2)));
typedef unsigned u32x4 __attribute__((ext_vector_type(4)));

constexpr int DM = 2048, NBATCH = 4, SEQ = 2048, DEPTH = 4, CTXL = 256;
constexpr int ML = NBATCH * SEQ, MC = NBATCH * CTXL, MT = ML + MC;
constexpr int NIN_SRC = 12864, NIN = 13056;
constexpr int FF = 5632;
constexpr float NORM_EPS = 1e-6f;
constexpr float ALPHA = 1.681792830507429f;
constexpr int LDACT = 5632;
constexpr int C_AQ = 0, C_AK = 512, C_AV = 768, C_BQ = 1024, C_BK = 1536, C_BV = 1792, C_CQ = 2048, C_CK = 2560, C_CV = 3072, C_DQ = 3584, C_DK = 4352, C_DV = 5120;

constexpr size_t MiB = 1u << 20;
constexpr size_t WS_CTL = 0, CTL_ZERO_BYTES = 1 * MiB;
constexpr size_t WS_ADA = 1 * MiB;
constexpr size_t WS_T128 = 2 * MiB;
constexpr size_t WS_T64 = 3 * MiB;
constexpr size_t WS_LAM = 3 * MiB + 512 * 1024;
constexpr size_t WS_SSQ = 4 * MiB;
constexpr size_t WS_X = 8 * MiB;
constexpr size_t SZ_F32ROWS = (size_t)MT * DM * 4;
constexpr size_t WS_PRE = WS_X + SZ_F32ROWS;
constexpr size_t WS_HB = WS_PRE + SZ_F32ROWS;
constexpr size_t SZ_BF16ROWS = (size_t)MT * DM * 2;
constexpr size_t WS_ACT = WS_HB + SZ_BF16ROWS;
constexpr size_t WS_DQKV = WS_ACT + (size_t)MT * LDACT * 2;
constexpr size_t WS_G = WS_DQKV + (size_t)2 * MT * 512 * 2;
constexpr size_t WS_OUTS = WS_G + (size_t)MT * 8192 * 2;
constexpr size_t WS_Y = WS_OUTS + SZ_BF16ROWS;
constexpr size_t WS_FH = WS_Y + SZ_BF16ROWS;
constexpr size_t WS_O1 = WS_FH + (size_t)MT * FF * 2;
constexpr size_t WS_W = WS_O1 + (size_t)MT * 512 * 4;
constexpr size_t WL_IN = 0, WL_UP = WL_IN + (size_t)NIN * DM * 2, WL_BR = WL_UP + (size_t)1792 * 512 * 2, WL_OUT = WL_BR + (size_t)8192 * 512 * 2,
                 WL_FI = WL_OUT + (size_t)DM * DM * 2, WL_FO = WL_FI + (size_t)2 * FF * DM * 2, WL_SIZE = WL_FO + (size_t)DM * FF * 2;
constexpr size_t WS_PART = WS_W + DEPTH * WL_SIZE;
constexpr size_t WS_END = WS_PART + (size_t)4 * MC * DM * 4;
static_assert(WS_SSQ + (size_t)MT * 16 * 4 <= WS_X && WS_ADA + (size_t)DEPTH * 5 * 6 * DM * 4 <= WS_T128, "ws map");
constexpr int CW_BAR = 4096;
constexpr int CW_QUEUE = 16384;

constexpr int RING_BYTES = 131072, LDSCTL_OFF = RING_BYTES, XCH_OFF = LDSCTL_OFF + 1024, LDS_BYTES = 147456;
static_assert(XCH_OFF + 8192 <= LDS_BYTES, "LDS map");

typedef __bf16 bf16x2_t __attribute__((ext_vector_type(2)));
__device__ __forceinline__ unsigned cvt_pk_bf16(float lo, float hi) { bf16x2_t v = {(__bf16)lo, (__bf16)hi}; return __builtin_bit_cast(unsigned, v); }
__device__ __forceinline__ float bf_lo(unsigned w) { return __uint_as_float(w << 16); }
__device__ __forceinline__ float bf_hi(unsigned w) { return __uint_as_float(w & 0xffff0000u); }
__device__ __forceinline__ float fast_sigmoid(float x) { return __builtin_amdgcn_rcpf(1.0f + __builtin_amdgcn_exp2f(-1.4426950408889634f * x)); }
__device__ __forceinline__ float wave_sum(float v) {
#pragma unroll
    for (int o = 1; o < 64; o <<= 1) v += __shfl_xor(v, o);
    return v;
}
__host__ __device__ __forceinline__ int L128(int p) { const int i = p >> 1, odd = p & 1; return i + 32 * odd + (i >= 32 ? 32 : 0); }
__host__ __device__ __forceinline__ int L64(int p) { const int i = p >> 1, odd = p & 1; return i + 16 * odd + (i >= 16 ? 16 : 0); }
__host__ __device__ __forceinline__ int win_src(int c) {
    const int t = c >> 8, w = c & 255;
    if (t >= 19) return 4672 + (c - 19 * 256);
    switch (t) {
        case 0: case 1: { const int cc = c; return 0 + (cc >> 7) * 128 + L128(cc & 127); }
        case 2: return 512 + (w >> 7) * 128 + L128(w & 127);
        case 3: return 768 + w;
        case 4: case 5: { const int cc = c - 1024; return 1024 + (cc >> 7) * 128 + L128(cc & 127); }
        case 6: return 1536 + (w >> 7) * 128 + L128(w & 127);
        case 7: return 1792 + w;
        case 8: case 9: { const int cc = c - 2048; return 2048 + (cc >> 6) * 64 + L64(cc & 63); }
        case 10: case 11: { const int cc = c - 2560; return 2560 + (cc >> 6) * 64 + L64(cc & 63); }
        case 12: case 13: return 3072 + (c - 3072);
        case 14: case 15: return 3584 + (c - 3584);
        case 16: case 17: return 4096 + (c - 4096);
        default: return 4608 + L64(w & 63);
    }
}

namespace pg8 {
constexpr int BM = 256, BK = 64, HALF = 128, HTB = HALF * BK * 2, STAGE_BYTES = 8 * HTB, NXCD = 8, WGM = 8;
__host__ __device__ __forceinline__ int lds_byte(int r, int c) { const int st = (r >> 4) * 2 + (c >> 5), rr = r & 15, cc = c & 31, ob = rr * 64 + cc * 2; return st * 1024 + (ob ^ (((ob >> 9) & 1) << 5)); }
__host__ __device__ __forceinline__ void stage_rc(int b, int& R, int& C) { const int st = b / 1024, sb = b % 1024, swz = sb ^ (((sb >> 9) & 1) << 5); R = (st >> 1) * 16 + swz / 64; C = (st & 1) * 32 + (swz % 64) / 2; }
__host__ __device__ __forceinline__ int perm32(int rho) { const int n = rho >> 4, i = rho & 15; return 8 * (i >> 2) + 4 * n + (i & 3); }
struct Unit { int pm, pn, ks; };
struct Gemm { const bf16_t* A; const bf16_t* Bt; int K, lda, ldb; };
template <int AMODE  > struct Order {
    int nM, nN, nwg, G, c; int lda, ldb, nt_full, nsub;
    __device__ void init(int nM_, int nN_, int G_, int c_, int lda_, int ldb_, int K_, int nsub_ = 0) { nM = nM_; nN = nN_; nwg = nM * nN; G = G_; c = c_; lda = lda_; ldb = ldb_; nt_full = K_ / BK; nsub = nsub_; }
    __device__ bool next(int i, Unit& u) const {
        const long L = (long)i * G + c; u.ks = -1;
        if (L >= nwg) { if (AMODE == 3) { const int idx = (int)(L - nwg); if (idx < nsub) { const int t = idx >> 2; u.ks = idx & 3; u.pm = 32 + t / nN; u.pn = t % nN; return true; } } return false; }
        int wgid = (int)L; { const int q = nwg / NXCD, r = nwg % NXCD, xcd = wgid % NXCD, off = wgid / NXCD; wgid = (xcd < r ? xcd * (q + 1) : r * (q + 1) + (xcd - r) * q) + off; }
        const int nig = WGM * nN, gid = wgid / nig, fm = gid * WGM, gsz = (nM - fm) < WGM ? (nM - fm) : WGM;
        u.pm = fm + ((wgid % nig) % gsz); u.pn = (wgid % nig) / gsz; return true;
    }
    __device__ __forceinline__ int kt(const Unit& u) const { return (AMODE == 3 && u.ks >= 0) ? (nt_full >> 2) : nt_full; }
    __device__ __forceinline__ size_t a_off(const Unit& u) const {
        size_t o = (size_t)u.pm * BM * lda;
        if (AMODE == 1) o += (size_t)(u.pn >> 3) * 512;
        if (AMODE == 2) o += (u.pn >= 3) ? (size_t)MT * 512 : 0;
        if (AMODE == 3) o += (u.ks > 0) ? (size_t)u.ks * (nt_full >> 2) * BK : 0;
        return o;
    }
    __device__ __forceinline__ size_t b_off(const Unit& u) const { size_t o = (size_t)u.pn * BM * ldb; if (AMODE == 3) o += (u.ks > 0) ? (size_t)u.ks * (nt_full >> 2) * BK : 0; return o; }
};

template <class Epi, class Sched>
__device__ __forceinline__ void gemm_phase(LAS unsigned char* lds, const Gemm g, const Sched& S, const Epi& E) {
    int tid_ = threadIdx.x; asm volatile("" : "+v"(tid_));
    const int tid = tid_, wid = __builtin_amdgcn_readfirstlane(tid >> 6), lane = tid & 63, wr = wid >> 2, wc = wid & 3, fr = lane & 15, fq = lane >> 4;
    unsigned voffA[2], voffB[2];
#pragma unroll
    for (int i = 0; i < 2; ++i) { int R, C; stage_rc(tid * 16 + i * 8192, R, C); const int Rb = Epi::PERM ? ((R & ~31) + perm32(R & 31)) : R;
        voffA[i] = (unsigned)(R * g.lda + C) * 2u; voffB[i] = (unsigned)(Rb * g.ldb + C) * 2u; }
    const size_t kstep = (size_t)(BK * 2);
    const size_t hstepA = (size_t)HALF * g.lda * 2, hstepB = (size_t)HALF * g.ldb * 2;
    const unsigned ldsw = (unsigned)wid * 1024u;
    const int aoff = lds_byte(wr * 64 + fr, fq * 8), boff = lds_byte(wc * 32 + fr, fq * 8);
#define PG8_SA(b, h) (((b) * 2 + (h)) * HTB)
#define PG8_SB(b, h) ((4 + (b) * 2 + (h)) * HTB)
#define PG8_STAGE(bufoff, gbase, voff) do { _Pragma("unroll") for (int _i = 0; _i < 2; ++_i) \
        __builtin_amdgcn_global_load_lds((const unsigned*)((const char*)(gbase) + (voff)[_i]), (LAS unsigned*)(lds + (bufoff) + ldsw + _i * 8192), 16, 0, 0); } while (0)
#define PG8_LDA(dst, b, h) do { _Pragma("unroll") for (int m = 0; m < 4; ++m) _Pragma("unroll") for (int k = 0; k < 2; ++k) dst[m][k] = *(const LAS bf16x8*)(lds + PG8_SA(b, h) + aoff + m * 2048 + k * 1024); } while (0)
#define PG8_LDB(dst, b, h) do { _Pragma("unroll") for (int n = 0; n < 2; ++n) _Pragma("unroll") for (int k = 0; k < 2; ++k) dst[n][k] = *(const LAS bf16x8*)(lds + PG8_SB(b, h) + boff + n * 2048 + k * 1024); } while (0)
#define PG8_MMA(ai, bj, At, Bt) do { __builtin_amdgcn_s_setprio(1); _Pragma("unroll") for (int m = 0; m < 4; ++m) _Pragma("unroll") for (int n = 0; n < 2; ++n) _Pragma("unroll") for (int k = 0; k < 2; ++k) \
        acc[ai][bj][m][n] = __builtin_amdgcn_mfma_f32_16x16x32_bf16(Bt[n][k], At[m][k], acc[ai][bj][m][n], 0, 0, 0); __builtin_amdgcn_s_setprio(0); } while (0)
#define PG8_WAIT_V(n) asm volatile("s_waitcnt vmcnt(" #n ")" ::: "memory")
#define PG8_WAIT_L(n) asm volatile("s_waitcnt lgkmcnt(" #n ")" ::: "memory")
#define PG8_BAR __builtin_amdgcn_s_barrier()
#define PG8_SCHED __builtin_amdgcn_sched_barrier(0)
    Unit cur, nxt; int ui = 0;
    if (!S.next(0, cur)) return;
    f32x4 acc[2][2][4][2];
#pragma unroll
    for (int a = 0; a < 2; ++a)
#pragma unroll
        for (int b = 0; b < 2; ++b)
#pragma unroll
            for (int m = 0; m < 4; ++m)
#pragma unroll
                for (int n = 0; n < 2; ++n) acc[a][b][m][n] = (f32x4){0.f, 0.f, 0.f, 0.f};
    bf16x8 At[4][2], B0[2][2], B1[2][2];
    const char* cA = (const char*)g.A + S.a_off(cur) * 2; const char* cB = (const char*)g.Bt + S.b_off(cur) * 2;
    PG8_STAGE(PG8_SB(0, 0), cB, voffB); PG8_STAGE(PG8_SB(0, 1), cB + hstepB, voffB); PG8_STAGE(PG8_SA(0, 0), cA, voffA); PG8_STAGE(PG8_SA(0, 1), cA + hstepA, voffA);
    if (wr == 1) PG8_BAR;
    PG8_WAIT_V(2); PG8_BAR;
    PG8_STAGE(PG8_SB(1, 0), cB + kstep, voffB); PG8_STAGE(PG8_SA(1, 0), cA + kstep, voffA); PG8_STAGE(PG8_SB(1, 1), cB + hstepB + kstep, voffB);
    PG8_WAIT_V(6); PG8_BAR;
    for (;;) {
        const bool has_next = S.next(ui + 1, nxt); const int nt = S.kt(cur);
        const char* nA = has_next ? (const char*)g.A + S.a_off(nxt) * 2 : cA; const char* nB = has_next ? (const char*)g.Bt + S.b_off(nxt) * 2 : cB;
        for (int t = 0; t < nt; t += 2) {
            const bool last = (t == nt - 2);
            const char* a1 = cA + (size_t)(t + 1) * kstep;
            const char* a2 = last ? nA : cA + (size_t)(t + 2) * kstep; const char* b2 = last ? nB : cB + (size_t)(t + 2) * kstep;
            const char* a3 = a2 + kstep; const char* b3 = b2 + kstep;
            PG8_LDB(B0, 0, 0); PG8_LDB(B1, 0, 1); PG8_SCHED; PG8_LDA(At, 0, 0); PG8_STAGE(PG8_SA(1, 1), a1 + hstepA, voffA);
            PG8_WAIT_V(8); PG8_WAIT_L(0); PG8_BAR; PG8_MMA(0, 0, At, B0); PG8_MMA(0, 1, At, B1); PG8_BAR; PG8_SCHED;
            PG8_LDA(At, 0, 1); PG8_STAGE(PG8_SB(0, 0), b2, voffB); PG8_STAGE(PG8_SB(0, 1), b2 + hstepB, voffB); PG8_STAGE(PG8_SA(0, 0), a2, voffA);
            PG8_WAIT_V(8); PG8_WAIT_L(0); PG8_BAR; PG8_MMA(1, 0, At, B0); PG8_MMA(1, 1, At, B1); PG8_BAR; PG8_SCHED;
            PG8_LDB(B0, 1, 0); PG8_LDB(B1, 1, 1); PG8_SCHED; PG8_LDA(At, 1, 0); PG8_STAGE(PG8_SA(0, 1), a2 + hstepA, voffA);
            PG8_WAIT_V(8); PG8_WAIT_L(0); PG8_BAR; PG8_MMA(0, 0, At, B0); PG8_MMA(0, 1, At, B1); PG8_BAR; PG8_SCHED;
            PG8_LDA(At, 1, 1); PG8_STAGE(PG8_SB(1, 0), b3, voffB); PG8_STAGE(PG8_SB(1, 1), b3 + hstepB, voffB); PG8_STAGE(PG8_SA(1, 0), a3, voffA);
            PG8_WAIT_V(8); PG8_WAIT_L(0); PG8_BAR; PG8_MMA(1, 0, At, B0); PG8_MMA(1, 1, At, B1); PG8_BAR; PG8_SCHED;
        }
        if (wr == 0) PG8_BAR;
        E(acc, cur, wr, wc, fr, fq);
        if (!has_next) break;
#pragma unroll
        for (int a = 0; a < 2; ++a)
#pragma unroll
            for (int b = 0; b < 2; ++b)
#pragma unroll
                for (int m = 0; m < 4; ++m)
#pragma unroll
                    for (int n = 0; n < 2; ++n) acc[a][b][m][n] = (f32x4){0.f, 0.f, 0.f, 0.f};
        cur = nxt; cA = nA; cB = nB; ++ui;
        if (wr == 1) PG8_BAR;
    }
    PG8_WAIT_V(0);
    PG8_BAR;
#undef PG8_SA
#undef PG8_SB
#undef PG8_STAGE
#undef PG8_LDA
#undef PG8_LDB
#undef PG8_MMA
#undef PG8_WAIT_V
#undef PG8_WAIT_L
#undef PG8_BAR
#undef PG8_SCHED
}

struct EpiIn {
    static constexpr bool PERM = true;
    bf16_t* act; bf16_t* gates; bf16_t* dqkv; float* ssq; const f32x4* t128; const f32x4* t64; const float* qkn; LAS float* xch;
    __device__ __forceinline__ void operator()(const f32x4 (&acc)[2][2][4][2], const Unit& u, int wr, int wc, int fr, int fq) const {
        const int pn = u.pn, row0 = u.pm * BM + wr * 64 + fr, tc0 = wc * 32 + 8 * fq;
        if (pn >= 19) {
#pragma unroll
            for (int ai = 0; ai < 2; ++ai)
#pragma unroll
                for (int m = 0; m < 4; ++m) { bf16_t* rowp = gates + (size_t)(row0 + ai * HALF + m * 16) * 8192 + (pn - 19) * 256 + tc0;
#pragma unroll
                    for (int bj = 0; bj < 2; ++bj) { const f32x4 v0 = acc[ai][bj][m][0], v1 = acc[ai][bj][m][1]; u32x4 w;
                        w.x = cvt_pk_bf16(fast_sigmoid(v0[0]), fast_sigmoid(v0[1])); w.y = cvt_pk_bf16(fast_sigmoid(v0[2]), fast_sigmoid(v0[3]));
                        w.z = cvt_pk_bf16(fast_sigmoid(v1[0]), fast_sigmoid(v1[1])); w.w = cvt_pk_bf16(fast_sigmoid(v1[2]), fast_sigmoid(v1[3]));
                        *(u32x4*)(rowp + bj * HALF) = w; } }
            return;
        }
        const bool plain = (pn == 3) | (pn == 7) | (pn == 12) | (pn == 13) | (pn >= 14 && pn <= 17);
        if (plain) {
            bf16_t* base; int ld;
            if (pn >= 14) { base = dqkv + (pn >= 16 ? (size_t)MT * 512 : 0) + (pn & 1) * 256 + tc0; ld = 512; } else { base = act + pn * 256 + tc0; ld = LDACT; }
#pragma unroll
            for (int ai = 0; ai < 2; ++ai)
#pragma unroll
                for (int m = 0; m < 4; ++m) { const int row = row0 + ai * HALF + m * 16; bf16_t* rowp = base + (size_t)row * ld; float ss = 0.f;
#pragma unroll
                    for (int bj = 0; bj < 2; ++bj) { const f32x4 v0 = acc[ai][bj][m][0], v1 = acc[ai][bj][m][1]; u32x4 w;
                        ss += (v0[0] * v0[0] + v0[1] * v0[1]) + (v0[2] * v0[2] + v0[3] * v0[3]) + (v1[0] * v1[0] + v1[1] * v1[1]) + (v1[2] * v1[2] + v1[3] * v1[3]);
                        w.x = cvt_pk_bf16(v0[0], v0[1]); w.y = cvt_pk_bf16(v0[2], v0[3]); w.z = cvt_pk_bf16(v1[0], v1[1]); w.w = cvt_pk_bf16(v1[2], v1[3]);
                        *(u32x4*)(rowp + bj * HALF) = w; }
                    if (pn >= 14) { ss += __shfl_xor(ss, 16); ss += __shfl_xor(ss, 32); if (fq == 0) ssq[(size_t)row * 16 + (pn - 14) * 4 + wc] = ss; } }
            return;
        }
        const bool r128 = pn < 8, rms = pn < 3, lat = u.pm < 32;
        float gn[2][4];
        if (rms) { const float* gq = qkn + (pn == 2 ? 128 : 0);
#pragma unroll
            for (int n = 0; n < 2; ++n)
#pragma unroll
                for (int j = 0; j < 4; ++j) gn[n][j] = gq[L128(tc0 + 4 * n + j)];
#pragma unroll
            for (int ai = 0; ai < 2; ++ai)
#pragma unroll
                for (int m = 0; m < 4; ++m)
#pragma unroll
                    for (int bj = 0; bj < 2; ++bj) { const f32x4 v0 = acc[ai][bj][m][0], v1 = acc[ai][bj][m][1];
                        float ss = (v0[0] * v0[0] + v0[1] * v0[1]) + (v0[2] * v0[2] + v0[3] * v0[3]) + (v1[0] * v1[0] + v1[1] * v1[1]) + (v1[2] * v1[2] + v1[3] * v1[3]);
                        ss += __shfl_xor(ss, 16); ss += __shfl_xor(ss, 32);
                        if (fq == 0) xch[((ai * HALF + wr * 64 + m * 16 + fr) * 2 + bj) * 4 + wc] = ss; }
            asm volatile("s_waitcnt lgkmcnt(0)" ::: "memory"); __builtin_amdgcn_s_barrier(); asm volatile("" ::: "memory");
        }
        const int i0 = r128 ? (wc * 16 + 4 * fq) : ((wc & 1) * 16 + 4 * fq);
#pragma unroll
        for (int ai = 0; ai < 2; ++ai)
#pragma unroll
            for (int m = 0; m < 4; ++m) { const int row = row0 + ai * HALF + m * 16, t = row & (SEQ - 1);
                f32x4 cs0 = (f32x4){1.f, 0.f, 1.f, 0.f}, cs1 = cs0;
                if (lat) { const f32x4* tp = r128 ? (t128 + ((size_t)t * 64 + i0) / 2) : (t64 + ((size_t)t * 32 + i0) / 2); cs0 = tp[0]; cs1 = tp[1]; }
#pragma unroll
                for (int bj = 0; bj < 2; ++bj) { f32x4 v0 = acc[ai][bj][m][0], v1 = acc[ai][bj][m][1];
                    if (rms) { const f32x4 p = *(const LAS f32x4*)(xch + ((ai * HALF + wr * 64 + m * 16 + fr) * 2 + bj) * 4);
                        const float rs = __builtin_amdgcn_rsqf(((p[0] + p[1]) + (p[2] + p[3])) * (1.0f / 128.0f) + NORM_EPS);
                        v0[0] *= rs * gn[0][0]; v0[1] *= rs * gn[0][1]; v0[2] *= rs * gn[0][2]; v0[3] *= rs * gn[0][3];
                        v1[0] *= rs * gn[1][0]; v1[1] *= rs * gn[1][1]; v1[2] *= rs * gn[1][2]; v1[3] *= rs * gn[1][3]; }
                    const float a0 = v0[0] * cs0[0] - v0[1] * cs0[1], b0 = v0[1] * cs0[0] + v0[0] * cs0[1];
                    const float a1 = v0[2] * cs0[2] - v0[3] * cs0[3], b1 = v0[3] * cs0[2] + v0[2] * cs0[3];
                    const float a2 = v1[0] * cs1[0] - v1[1] * cs1[1], b2 = v1[1] * cs1[0] + v1[0] * cs1[1];
                    const float a3 = v1[2] * cs1[2] - v1[3] * cs1[3], b3 = v1[3] * cs1[2] + v1[2] * cs1[3];
                    u32x4 w; w.x = cvt_pk_bf16(a0, b0); w.y = cvt_pk_bf16(a1, b1); w.z = cvt_pk_bf16(a2, b2); w.w = cvt_pk_bf16(a3, b3);
                    bf16_t* dst;
                    if (pn == 18) { const int c = bj * HALF + tc0; dst = act + (size_t)row * LDACT + C_DK + (c >> 6) * 192 + 128 + (c & 63); }
                    else dst = act + (size_t)row * LDACT + pn * 256 + bj * HALF + tc0;
                    *(u32x4*)dst = w; } }
    }
};
struct EpiUp {
    static constexpr bool PERM = true;
    bf16_t* act; const float* ssq; const f32x4* t64;
    __device__ __forceinline__ void operator()(const f32x4 (&acc)[2][2][4][2], const Unit& u, int wr, int wc, int fr, int fq) const {
        const int pn = u.pn, row0 = u.pm * BM + wr * 64 + fr, tc0 = wc * 32 + 8 * fq; const bool lat = u.pm < 32;
        const int i0 = (wc & 1) * 16 + 4 * fq;
#pragma unroll
        for (int ai = 0; ai < 2; ++ai)
#pragma unroll
            for (int m = 0; m < 4; ++m) { const int row = row0 + ai * HALF + m * 16, t = row & (SEQ - 1);
                const f32x4* sp = (const f32x4*)(ssq + (size_t)row * 16 + (pn >= 3 ? 8 : 0)); const f32x4 s0 = sp[0], s1 = sp[1];
                const float rs = __builtin_amdgcn_rsqf((((s0[0] + s0[1]) + (s0[2] + s0[3])) + ((s1[0] + s1[1]) + (s1[2] + s1[3]))) * (1.0f / 512.0f) + NORM_EPS);
                f32x4 cs0 = (f32x4){1.f, 0.f, 1.f, 0.f}, cs1 = cs0;
                if (pn == 2 && lat) { const f32x4* tp = t64 + ((size_t)t * 32 + i0) / 2; cs0 = tp[0]; cs1 = tp[1]; }
#pragma unroll
                for (int bj = 0; bj < 2; ++bj) { f32x4 v0 = acc[ai][bj][m][0] * rs, v1 = acc[ai][bj][m][1] * rs; u32x4 w;
                    if (pn == 2) {
                        const float a0 = v0[0] * cs0[0] - v0[1] * cs0[1], b0 = v0[1] * cs0[0] + v0[0] * cs0[1];
                        const float a1 = v0[2] * cs0[2] - v0[3] * cs0[3], b1 = v0[3] * cs0[2] + v0[2] * cs0[3];
                        const float a2 = v1[0] * cs1[0] - v1[1] * cs1[1], b2 = v1[1] * cs1[0] + v1[0] * cs1[1];
                        const float a3 = v1[2] * cs1[2] - v1[3] * cs1[3], b3 = v1[3] * cs1[2] + v1[2] * cs1[3];
                        w.x = cvt_pk_bf16(a0, b0); w.y = cvt_pk_bf16(a1, b1); w.z = cvt_pk_bf16(a2, b2); w.w = cvt_pk_bf16(a3, b3);
                    } else { w.x = cvt_pk_bf16(v0[0], v0[1]); w.y = cvt_pk_bf16(v0[2], v0[3]); w.z = cvt_pk_bf16(v1[0], v1[1]); w.w = cvt_pk_bf16(v1[2], v1[3]); }
                    const int c = bj * HALF + tc0; int col;
                    if (pn < 2) col = C_DQ + (pn * 2 + bj) * 192 + tc0;
                    else if (pn == 2) col = C_DQ + (c >> 6) * 192 + 128 + (c & 63);
                    else if (pn < 5) col = C_DK + ((pn - 3) * 2 + bj) * 192 + tc0;
                    else col = C_DV + (pn - 5) * 256 + c;
                    *(u32x4*)(act + (size_t)row * LDACT + col) = w; } }
    }
};
struct EpiMerge {
    static constexpr bool PERM = true;
    bf16_t* gates;
    __device__ __forceinline__ void operator()(const f32x4 (&acc)[2][2][4][2], const Unit& u, int wr, int wc, int fr, int fq) const {
        const int row0 = u.pm * BM + wr * 64 + fr, tc0 = wc * 32 + 8 * fq;
#pragma unroll
        for (int ai = 0; ai < 2; ++ai)
#pragma unroll
            for (int m = 0; m < 4; ++m) { bf16_t* rowp = gates + (size_t)(row0 + ai * HALF + m * 16) * 8192 + u.pn * 256 + tc0;
                u32x4 gv[2];
#pragma unroll
                for (int bj = 0; bj < 2; ++bj) gv[bj] = *(const u32x4*)(rowp + bj * HALF);
#pragma unroll
                for (int bj = 0; bj < 2; ++bj) { const f32x4 v0 = acc[ai][bj][m][0], v1 = acc[ai][bj][m][1]; const u32x4 g = gv[bj]; u32x4 w;
                    w.x = cvt_pk_bf16(v0[0] * bf_lo(g.x), v0[1] * bf_hi(g.x)); w.y = cvt_pk_bf16(v0[2] * bf_lo(g.y), v0[3] * bf_hi(g.y));
                    w.z = cvt_pk_bf16(v1[0] * bf_lo(g.z), v1[1] * bf_hi(g.z)); w.w = cvt_pk_bf16(v1[2] * bf_lo(g.w), v1[3] * bf_hi(g.w));
                    *(u32x4*)(rowp + bj * HALF) = w; } }
    }
};
struct EpiRes {
    static constexpr bool PERM = false;
    const float* x; float* pre; const float* gvec; float* part;
    __device__ __forceinline__ void operator()(const f32x4 (&acc)[2][2][4][2], const Unit& u, int wr, int wc, int fr, int fq) const {
        const int row0 = u.pm * BM + wr * 64 + fr, col0 = u.pn * BM + wc * 32 + 4 * fq;
        const float* gp = gvec + (size_t)(u.pm < 32 ? (u.pm >> 3) : 4) * (6 * DM) + col0;
        const float al = (u.ks > 0) ? 0.0f : ALPHA;
        float* dst = (u.ks >= 0) ? part + ((size_t)u.ks * MC - ML) * DM : pre;
        f32x4 gv[2][2];
#pragma unroll
        for (int bj = 0; bj < 2; ++bj)
#pragma unroll
            for (int n = 0; n < 2; ++n) gv[bj][n] = *(const f32x4*)(gp + bj * HALF + n * 16);
#pragma unroll
        for (int ai = 0; ai < 2; ++ai)
#pragma unroll
            for (int m = 0; m < 4; ++m) { const size_t off = (size_t)(row0 + ai * HALF + m * 16) * DM + col0;
#pragma unroll
                for (int bj = 0; bj < 2; ++bj)
#pragma unroll
                    for (int n = 0; n < 2; ++n) { const f32x4 xv = *(const f32x4*)(x + off + bj * HALF + n * 16);
                        *(f32x4*)(dst + off + bj * HALF + n * 16) = xv * al + gv[bj][n] * acc[ai][bj][m][n]; }
                asm volatile("" ::: "memory"); }
    }
};
struct EpiSwi {
    static constexpr bool PERM = true;
    bf16_t* fh;
    __device__ __forceinline__ void operator()(const f32x4 (&acc)[2][2][4][2], const Unit& u, int wr, int wc, int fr, int fq) const {
        const int row0 = u.pm * BM + wr * 64 + fr, col0 = u.pn * 128 + wc * 32 + 8 * fq;
#pragma unroll
        for (int ai = 0; ai < 2; ++ai)
#pragma unroll
            for (int m = 0; m < 4; ++m) { const f32x4 g0 = acc[ai][0][m][0], g1 = acc[ai][0][m][1], u0 = acc[ai][1][m][0], u1 = acc[ai][1][m][1]; u32x4 w;
                w.x = cvt_pk_bf16(g0[0] * fast_sigmoid(g0[0]) * u0[0], g0[1] * fast_sigmoid(g0[1]) * u0[1]);
                w.y = cvt_pk_bf16(g0[2] * fast_sigmoid(g0[2]) * u0[2], g0[3] * fast_sigmoid(g0[3]) * u0[3]);
                w.z = cvt_pk_bf16(g1[0] * fast_sigmoid(g1[0]) * u1[0], g1[1] * fast_sigmoid(g1[1]) * u1[1]);
                w.w = cvt_pk_bf16(g1[2] * fast_sigmoid(g1[2]) * u1[2], g1[3] * fast_sigmoid(g1[3]) * u1[3]);
                *(u32x4*)(fh + (size_t)(row0 + ai * HALF + m * 16) * FF + col0) = w; }
    }
};
}

namespace att {
constexpr int NW = 8, QBLK = 32, KVBLK = 64;
constexpr int SHM_V = KVBLK * 128 * 2;
#define SBAR() __builtin_amdgcn_sched_barrier(0)
__device__ __forceinline__ int crow(int r, int hi) { return (r & 3) + 8 * (r >> 2) + 4 * hi; }
__device__ __forceinline__ int v_st(int k, int c) { const int kk = (k & ~0xC) | ((k & 4) << 1) | ((k & 8) >> 1); return ((kk >> 3) * 4 + (c >> 5)) * 512 + ((kk & 7) * 32 + (c & 31)) * 2; }
__device__ __forceinline__ int v_rd_base(int lane) { return ((lane & 3) << 3) | (((lane >> 2) & 3) << 6) | (((lane >> 4) & 1) << 5) | (((lane >> 5) & 1) << 8); }
constexpr int v_rd_off(int d0, int ks, int half) { return d0 * 512 + ks * 4096 + half * 2048; }
template <int OFF> __device__ __forceinline__ s16x4 tr_read(int vb) { s16x4 r; asm volatile("ds_read_b64_tr_b16 %0, %1 offset:%2" : "=&v"(r) : "v"(vb), "i"(OFF) : "memory"); return r; }
template <int D0> __device__ __forceinline__ void pv_one(f32x16& od, int vb, bf16x8 pa0, bf16x8 pa1, bf16x8 pa2, bf16x8 pa3) {
    const s16x4 l0 = tr_read<v_rd_off(D0, 0, 0)>(vb), h0 = tr_read<v_rd_off(D0, 0, 1)>(vb), l1 = tr_read<v_rd_off(D0, 1, 0)>(vb), h1 = tr_read<v_rd_off(D0, 1, 1)>(vb);
    const s16x4 l2 = tr_read<v_rd_off(D0, 2, 0)>(vb), h2 = tr_read<v_rd_off(D0, 2, 1)>(vb), l3 = tr_read<v_rd_off(D0, 3, 0)>(vb), h3 = tr_read<v_rd_off(D0, 3, 1)>(vb);
    asm volatile("s_waitcnt lgkmcnt(0)" ::: "memory"); SBAR();
#define PK(L, H) (bf16x8){L[0], L[1], L[2], L[3], H[0], H[1], H[2], H[3]}
    od = __builtin_amdgcn_mfma_f32_32x32x16_bf16(pa0, PK(l0, h0), od, 0, 0, 0);
    od = __builtin_amdgcn_mfma_f32_32x32x16_bf16(pa1, PK(l1, h1), od, 0, 0, 0);
    od = __builtin_amdgcn_mfma_f32_32x32x16_bf16(pa2, PK(l2, h2), od, 0, 0, 0);
    od = __builtin_amdgcn_mfma_f32_32x32x16_bf16(pa3, PK(l3, h3), od, 0, 0, 0);
#undef PK
}
__device__ __forceinline__ void pv_d0(f32x16* o, int vb, bf16x8 pa0, bf16x8 pa1, bf16x8 pa2, bf16x8 pa3) {
    pv_one<0>(o[0], vb, pa0, pa1, pa2, pa3); pv_one<1>(o[1], vb, pa0, pa1, pa2, pa3); pv_one<2>(o[2], vb, pa0, pa1, pa2, pa3); pv_one<3>(o[3], vb, pa0, pa1, pa2, pa3);
}
template <bool BAND>
__device__ __forceinline__ void partialSM(f32x16& p0, f32x16& p1, float& m_reg, float& mn, float& alpha, const float C, const float thr, bool domask, int dk, int hi) {
    if (BAND) { if (domask) {
#pragma unroll
        for (int r = 0; r < 16; ++r) { const int kk = dk + crow(r, hi); if ((unsigned)(kk + 128) > 256u) p0[r] = -1e30f; if ((unsigned)(kk + 160) > 256u) p1[r] = -1e30f; } } }
    float pmax = p0[0];
#pragma unroll
    for (int r = 1; r < 16; ++r) pmax = fmaxf(pmax, p0[r]);
#pragma unroll
    for (int r = 0; r < 16; ++r) pmax = fmaxf(pmax, p1[r]);
    { auto rr = __builtin_amdgcn_permlane32_swap(__float_as_uint(pmax), __float_as_uint(pmax), false, false); pmax = fmaxf(__uint_as_float(rr[0]), __uint_as_float(rr[1])); }
    if (__builtin_expect(__all(pmax - m_reg <= thr), 1)) { mn = m_reg; alpha = 1.f; }
    else { mn = fmaxf(m_reg, pmax); alpha = __builtin_amdgcn_exp2f((m_reg - mn) * C); m_reg = mn; }
    const float mnC = -mn * C;
#pragma unroll
    for (int r = 0; r < 16; ++r) p0[r] = fmaf(p0[r], C, mnC);
#pragma unroll
    for (int r = 0; r < 16; ++r) p1[r] = fmaf(p1[r], C, mnC);
#pragma unroll
    for (int r = 0; r < 16; ++r) p0[r] = __builtin_amdgcn_exp2f(p0[r]);
}
__device__ __forceinline__ void finishSM(f32x16& p0, f32x16& p1, float alpha, float& l_reg, bf16x8& pa0, bf16x8& pa1, bf16x8& pa2, bf16x8& pa3) {
#pragma unroll
    for (int r = 0; r < 16; ++r) p1[r] = __builtin_amdgcn_exp2f(p1[r]);
    float ps = 0;
#pragma unroll
    for (int r = 0; r < 16; ++r) ps += p0[r];
#pragma unroll
    for (int r = 0; r < 16; ++r) ps += p1[r];
    { auto rr = __builtin_amdgcn_permlane32_swap(__float_as_uint(ps), __float_as_uint(ps), false, false); ps = __uint_as_float(rr[0]) + __uint_as_float(rr[1]); }
    l_reg = l_reg * alpha + ps;
#define PK4(P, BASE, OUT) do { unsigned a0 = cvt_pk_bf16(P[BASE + 0], P[BASE + 1]), a1 = cvt_pk_bf16(P[BASE + 2], P[BASE + 3]);   \
    unsigned b0 = cvt_pk_bf16(P[BASE + 4], P[BASE + 5]), b1 = cvt_pk_bf16(P[BASE + 6], P[BASE + 7]);                              \
    auto r0 = __builtin_amdgcn_permlane32_swap(a0, b0, false, false); auto r1 = __builtin_amdgcn_permlane32_swap(a1, b1, false, false); \
    u32x4 w = {r0[0], r1[0], r0[1], r1[1]}; OUT = *reinterpret_cast<bf16x8*>(&w); } while (0)
    PK4(p0, 0, pa0); PK4(p0, 8, pa1); PK4(p1, 0, pa2); PK4(p1, 8, pa3);
#undef PK4
}
#define KSWZP(row, colB, PITCH) ((row) * (PITCH) + ((colB) ^ (((row) & 7) << 4)))
template <int DQK>
__device__ __forceinline__ void qkt(f32x16& p0, f32x16& p1, const char* Ks, const bf16x8* qr, int r32, int hi) {
    p0 = f32x16{}; p1 = f32x16{};
#pragma unroll
    for (int d0 = 0; d0 < DQK / 16; ++d0) { const int cb = (d0 * 16 + hi * 8) * 2;
        const bf16x8 b0 = *reinterpret_cast<const bf16x8*>(Ks + KSWZP(r32, cb, DQK * 2));
        const bf16x8 b1 = *reinterpret_cast<const bf16x8*>(Ks + KSWZP(32 + r32, cb, DQK * 2));
        p0 = __builtin_amdgcn_mfma_f32_32x32x16_bf16(b0, qr[d0], p0, 0, 0, 0);
        p1 = __builtin_amdgcn_mfma_f32_32x32x16_bf16(b1, qr[d0], p1, 0, 0, 0); }
}
struct UnitArgs {
    const bf16_t* Qb; int ldq;
    const bf16_t* Kb; int ldk;
    const bf16_t* Vb; int ldv;
    int crow0, lrow0, ntc, nt;
    int dpos;
    float sink;
    bf16_t* out; int ldo;
    float* scr;
    float lam, omli; const float* gsub;
    int epi;
};
template <int DQK, bool BAND, bool SINK, int EPI>
__device__ __forceinline__ void attn_unit(const UnitArgs& a, char* lds) {
    constexpr int SDEPTH = (DQK == 192) ? 1 : 2;
    constexpr int NKC = DQK / 64, CH = DQK / 8, SHM_K = KVBLK * DQK * 2;
    constexpr float SCALE = (DQK == 64) ? 0.125f : (DQK == 128 ? 0.088388347648318440f : 0.072168783648703220f);
    constexpr float C = SCALE * 1.4426950408889634f, THRS = 8.0f / SCALE;
    int tid_ = threadIdx.x; asm volatile("" : "+v"(tid_));
    const int tid = tid_, wid = tid >> 6, lane = tid & 63, r32 = lane & 31, hi = lane >> 5;
    char* V_lds = lds; char* K_lds = lds + 2 * SHM_V;
    float* wsf = (float*)(lds + 2 * SHM_V + 2 * SHM_K) + wid * 64; float* li_l = wsf; float* al_l = wsf + 32;
    float m_reg = -1e30f, l_reg = 0; f32x16 o[4] = {}; bf16x8 qr[DQK / 16];
    const bf16_t* Qw = a.Qb + (long)(wid * QBLK + r32) * a.ldq + hi * 8;
#pragma unroll
    for (int d0 = 0; d0 < DQK / 16; ++d0) qr[d0] = *reinterpret_cast<const bf16x8*>(Qw + d0 * 16);
    const int sr = tid >> 4, sc = (tid & 15) * 8, vst0 = v_st(sr, sc), vst1 = v_st(32 + sr, sc);
#define KCOORD(q_, KR, KC) int t__ = tid; if constexpr (NKC == 3) asm volatile("" : "+v"(t__)); const int qq__ = t__ + 512 * (q_); const int KR = qq__ / CH, KC = (qq__ % CH) * 8;
    const int vb0 = (int)(uintptr_t)V_lds + v_rd_base(lane);
    struct { bf16x8 vs0, vs1, ks[NKC]; } sr_[SDEPTH];
    const int dk0 = a.dpos - wid * QBLK - r32;
#define TROW(j) (((j) < a.ntc) ? (a.crow0 + KVBLK * (j)) : (a.lrow0 + KVBLK * ((j) - a.ntc)))
#define SLOAD(i, j) do { const int R0_ = TROW(j); sr_[i].vs0 = *reinterpret_cast<const bf16x8*>(a.Vb + (long)(R0_ + sr) * a.ldv + sc); sr_[i].vs1 = *reinterpret_cast<const bf16x8*>(a.Vb + (long)(R0_ + 32 + sr) * a.ldv + sc); \
    _Pragma("unroll") for (int q_ = 0; q_ < NKC; ++q_) { KCOORD(q_, kr_, kc_) sr_[i].ks[q_] = *reinterpret_cast<const bf16x8*>(a.Kb + (long)(R0_ + kr_) * a.ldk + kc_); } } while (0)
#define SWRITE(b, i) do { *(bf16x8*)(V_lds + (b) * SHM_V + vst0) = sr_[i].vs0; *(bf16x8*)(V_lds + (b) * SHM_V + vst1) = sr_[i].vs1; \
    _Pragma("unroll") for (int q_ = 0; q_ < NKC; ++q_) { KCOORD(q_, kr_, kc_) *(bf16x8*)(K_lds + (b) * SHM_K + KSWZP(kr_, kc_ * 2, DQK * 2)) = sr_[i].ks[q_]; } } while (0)
#define SWAIT() do { if constexpr (SDEPTH == 2) { if constexpr (NKC == 1) asm volatile("s_waitcnt vmcnt(3)" ::: "memory"); else asm volatile("s_waitcnt vmcnt(4)" ::: "memory"); } else asm volatile("s_waitcnt vmcnt(0)" ::: "memory"); } while (0)
#define RESC(al) do { if (__any((al) < 1.f)) { if (hi == 0) al_l[r32] = (al); asm volatile("s_waitcnt lgkmcnt(0)" ::: "memory"); \
    _Pragma("unroll") for (int d = 0; d < 4; ++d) _Pragma("unroll") for (int r = 0; r < 16; ++r) o[d][r] *= al_l[crow(r, hi)]; } } while (0)
#define PSM(P0, P1, MN, AL, j) partialSM<BAND>(P0, P1, m_reg, MN, AL, C, THRS, (j) >= a.ntc, dk0 + KVBLK * ((j) - a.ntc), hi)
    f32x16 pA0, pA1, pB0, pB1; float mnA, mnB, alA, alB; bf16x8 pa0, pa1, pa2, pa3; const int NT = a.nt;
    constexpr int SE = 0, SO = SDEPTH - 1;
    SLOAD(SE, 0); asm volatile("s_waitcnt vmcnt(0)" ::: "memory"); SWRITE(0, SE); __syncthreads();
    qkt<DQK>(pA0, pA1, K_lds, qr, r32, hi); PSM(pA0, pA1, mnA, alA, 0);
    SLOAD(SO, 1); if constexpr (SDEPTH == 2) { if (2 < NT) SLOAD(SE, 2); }
    SWAIT(); SWRITE(1, SO); __syncthreads();
    for (int j = 1; j + 1 < NT; j += 2) {
        SBAR(); qkt<DQK>(pB0, pB1, K_lds + SHM_K, qr, r32, hi);
        finishSM(pA0, pA1, alA, l_reg, pa0, pa1, pa2, pa3); SBAR();
        SLOAD(SO, j + SDEPTH); SBAR();
        pv_d0(o, vb0, pa0, pa1, pa2, pa3); PSM(pB0, pB1, mnB, alB, j);
        __syncthreads(); SWAIT(); SWRITE(0, SE);
        RESC(alB); __syncthreads();
        SBAR(); qkt<DQK>(pA0, pA1, K_lds, qr, r32, hi);
        finishSM(pB0, pB1, alB, l_reg, pa0, pa1, pa2, pa3); SBAR();
        if (SDEPTH == 1 || j + 3 < NT) SLOAD(SE, j + 1 + SDEPTH); SBAR();
        pv_d0(o, vb0 + SHM_V, pa0, pa1, pa2, pa3); PSM(pA0, pA1, mnA, alA, j + 1);
        __syncthreads(); SWAIT(); SWRITE(1, SO);
        RESC(alA); __syncthreads();
    }
    SBAR(); qkt<DQK>(pB0, pB1, K_lds + SHM_K, qr, r32, hi);
    finishSM(pA0, pA1, alA, l_reg, pa0, pa1, pa2, pa3); SBAR();
    pv_d0(o, vb0, pa0, pa1, pa2, pa3); PSM(pB0, pB1, mnB, alB, NT - 1);
    __syncthreads(); RESC(alB);
    finishSM(pB0, pB1, alB, l_reg, pa0, pa1, pa2, pa3); SBAR();
    pv_d0(o, vb0 + SHM_V, pa0, pa1, pa2, pa3);
    if (SINK) l_reg += __builtin_amdgcn_exp2f(a.sink * 1.4426950408889634f - m_reg * C);
    if (hi == 0) li_l[r32] = l_reg; asm volatile("s_waitcnt lgkmcnt(0)" ::: "memory");
    float rli[16];
#pragma unroll
    for (int r = 0; r < 16; ++r) rli[r] = __builtin_amdgcn_rcpf(li_l[crow(r, hi)]);
#define OROW(r) int orow = crow(r, hi); asm volatile("" : "+v"(orow));
    if (EPI == 0) {
        bf16_t* Ow = a.out + (long)(wid * QBLK) * a.ldo + r32;
#pragma unroll
        for (int r = 0; r < 16; ++r) { OROW(r) bf16_t* op = Ow + (long)orow * a.ldo;
#pragma unroll
            for (int d0 = 0; d0 < 4; ++d0) op[d0 * 32] = (bf16_t)(cvt_pk_bf16(o[d0][r] * rli[r], 0.f) & 0xffffu); }
    } else if (EPI == 1) {
        float* Sw = a.scr + (long)(wid * QBLK) * 512 + r32;
#pragma unroll
        for (int r = 0; r < 16; ++r) { OROW(r) float* sp = Sw + (long)orow * 512;
#pragma unroll
            for (int d0 = 0; d0 < 4; ++d0) sp[d0 * 32] = o[d0][r] * rli[r]; }
        asm volatile("s_waitcnt vmcnt(0)" ::: "memory");
    } else {
        const float* Sw = a.scr + (long)(wid * QBLK) * 512 + r32; bf16_t* Ow = a.out + (long)(wid * QBLK) * a.ldo + r32;
#pragma unroll
        for (int r = 0; r < 16; ++r) { OROW(r) const float* sp = Sw + (long)orow * 512; bf16_t* op = Ow + (long)orow * a.ldo; float d[4]; float ss = 0.f;
#pragma unroll
            for (int d0 = 0; d0 < 4; ++d0) { d[d0] = sp[d0 * 32] - a.lam * (o[d0][r] * rli[r]); ss += d[d0] * d[d0]; }
            ss += __shfl_xor(ss, 1); ss += __shfl_xor(ss, 2); ss += __shfl_xor(ss, 4); ss += __shfl_xor(ss, 8); ss += __shfl_xor(ss, 16);
            const float rs = __builtin_amdgcn_rsqf(ss * (1.0f / 128.0f) + NORM_EPS) * a.omli;
#pragma unroll
            for (int d0 = 0; d0 < 4; ++d0) op[d0 * 32] = (bf16_t)(cvt_pk_bf16(d[d0] * rs * a.gsub[d0 * 32 + r32], 0.f) & 0xffffu);
            if ((r & 3) == 3) asm volatile("" ::: "memory"); }
    }
#undef OROW
    __syncthreads();
#undef TROW
#undef KCOORD
#undef SLOAD
#undef SWRITE
#undef SWAIT
#undef RESC
#undef PSM
}
}

#define XB_TMO      128
#define XB_XCNT(j)  (256  + 64 * (j))
#define XB_XSUB(j)  (1280 + 64 * (j))
#define XB_XGEN(j)  (2304 + 64 * (j))
#define XB_TOP      3328
#define XB_TOPGEN   3392
#define XCD_BAR_WORDS 3456
#define XB_SPIN_CAP (1u << 18)
__device__ __forceinline__ unsigned xb_ld(unsigned* p)              { return __hip_atomic_load(p, __ATOMIC_RELAXED, __HIP_MEMORY_SCOPE_AGENT); }
__device__ __forceinline__ unsigned xb_add(unsigned* p, unsigned v) { return __hip_atomic_fetch_add(p, v, __ATOMIC_RELAXED, __HIP_MEMORY_SCOPE_AGENT); }
__device__ __forceinline__ unsigned xb_xcc_id() { return (unsigned)__builtin_amdgcn_s_getreg((3 << 11) | 20) & 0xFu; }
#define XB_SPIN(cond, bar) do { unsigned _sp = 0; while (cond) { __builtin_amdgcn_s_sleep(1); \
    if ((++_sp & 255u) == 0u) { if (xb_ld(&(bar)[XB_TMO])) break; if (_sp > XB_SPIN_CAP) { atomicAdd(&(bar)[XB_TMO], 1u); break; } } } } while (0)
struct XcdBarrier { unsigned* bar; unsigned x; volatile LAS unsigned* st; };
__device__ __forceinline__ XcdBarrier xcd_barrier_post(unsigned* bar, volatile LAS unsigned* st) {
    XcdBarrier b; b.bar = bar; b.x = xb_xcc_id(); b.st = st;
    if (threadIdx.x == 0) (void)xb_add(&bar[XB_XCNT(b.x)], 1u);
    return b;
}
__device__ __forceinline__ void xcd_barrier_complete(unsigned* bar, unsigned x, unsigned& nloc, unsigned& nx) {
    const unsigned G = gridDim.x * gridDim.y * gridDim.z;
    unsigned sum, cnt, mine, sp = 0u;
    for (;;) {
        sum = 0u; cnt = 0u; mine = 0u;
#pragma unroll
        for (unsigned j = 0; j < 16; ++j) { const unsigned c = xb_ld(&bar[XB_XCNT(j)]); sum += c; cnt += (c > 0u) ? 1u : 0u; mine = (j == x) ? c : mine; }
        if (sum == G) break;
        __builtin_amdgcn_s_sleep(1);
        if ((++sp & 255u) == 0u) { if (xb_ld(&bar[XB_TMO])) break; if (sp > XB_SPIN_CAP) { atomicAdd(&bar[XB_TMO], 1u); break; } }
    }
    nloc = mine > 0u ? mine : 1u; nx = cnt > 0u ? cnt : 1u;
}
__device__ __forceinline__ void xcd_barrier(const XcdBarrier& b) {
    asm volatile("s_waitcnt vmcnt(0)" ::: "memory");
    __syncthreads();
    if (threadIdx.x == 0) {
        unsigned* bar = b.bar;
        __builtin_amdgcn_s_waitcnt(0);
        unsigned nloc = b.st[0], nx = b.st[1];
        if (nloc == 0u) { xcd_barrier_complete(bar, b.x, nloc, nx); b.st[0] = nloc; b.st[1] = nx; }
        const unsigned old = xb_add(&bar[XB_XSUB(b.x)], 1u);
        const unsigned gen = old / nloc;
        if (old + 1u == (gen + 1u) * nloc) {
            __builtin_amdgcn_fence(__ATOMIC_RELEASE, "agent");
            asm volatile("s_waitcnt vmcnt(0)" ::: "memory");
            const unsigned og = xb_add(&bar[XB_TOP], 1u);
            const unsigned tg = og / nx;
            if (og + 1u == (tg + 1u) * nx) xb_add(&bar[XB_TOPGEN], 1u);
            else XB_SPIN(xb_ld(&bar[XB_TOPGEN]) == tg, bar);
            __builtin_amdgcn_fence(__ATOMIC_ACQUIRE, "agent");
            xb_add(&bar[XB_XGEN(b.x)], 1u);
            asm volatile("s_waitcnt vmcnt(0)" ::: "memory");
        } else {
            XB_SPIN(xb_ld(&bar[XB_XGEN(b.x)]) == gen, bar);
            __builtin_amdgcn_fence(__ATOMIC_ACQUIRE, "agent");
            asm volatile("s_waitcnt vmcnt(0)" ::: "memory");
        }
    }
    __syncthreads();
}

struct Args {
    const float* in[23];
    float* out; unsigned char* ws;
    int ph_lo, ph_hi;
};
typedef const __attribute__((address_space(4))) Args* ArgsP;
enum { I_X = 0, I_C, I_CTX, I_CCTX, I_WADA, I_BADA, I_WIN, I_AQKN, I_BSINK, I_CLAM, I_CSUBLN, I_MQN, I_MWQ, I_MKVN, I_MWKV, I_WBR, I_WOUT, I_LMG, I_LMB, I_WFI, I_WFO, I_LFG, I_LFB };
constexpr int NPH_LAYER = 10, NPH_PRO = 2, NPH_TOTAL = NPH_PRO + DEPTH * NPH_LAYER;

template <class SrcFn>
__device__ __forceinline__ void cvt_item(const float* W, int K, int Nsrc, bf16_t* WT, const float* kscale, LAS float* scr, int kb, int nb, int lane, SrcFn srcf) {
    const int k0 = 64 * kb, n0 = 32 * nb; const int sc = srcf(n0 + (lane & 31));
    float v[32];
    const float* wp = W + (size_t)(k0 + (lane >> 5)) * Nsrc + sc;
#pragma unroll
    for (int i = 0; i < 32; ++i) v[i] = wp[(size_t)(2 * i) * Nsrc];
    if (kscale) {
#pragma unroll
        for (int i = 0; i < 32; ++i) v[i] *= kscale[k0 + 2 * i + (lane >> 5)]; }
#pragma unroll
    for (int i = 0; i < 32; ++i) scr[(2 * i + (lane >> 5)) * 33 + (lane & 31)] = v[i];
    asm volatile("s_waitcnt lgkmcnt(0)" ::: "memory");
    const int c = lane & 7;
#pragma unroll
    for (int j = 0; j < 4; ++j) { const int n = (lane >> 3) + 8 * j; const LAS float* s = scr + (8 * c) * 33 + n;
        u32x4 o; o.x = cvt_pk_bf16(s[0 * 33], s[1 * 33]); o.y = cvt_pk_bf16(s[2 * 33], s[3 * 33]); o.z = cvt_pk_bf16(s[4 * 33], s[5 * 33]); o.w = cvt_pk_bf16(s[6 * 33], s[7 * 33]);
        *(u32x4*)(WT + (size_t)(n0 + n) * K + k0 + 8 * c) = o; }
    asm volatile("s_waitcnt lgkmcnt(0)" ::: "memory");
}
constexpr int IT_IN = (DM / 64) * (NIN / 32), IT_QUP = (512 / 64) * (768 / 32), IT_KVUP = (512 / 64) * (1024 / 32), IT_BR = 4 * (512 / 64) * (DM / 32), IT_OUT = (DM / 64) * (DM / 32),
              IT_FI = (DM / 64) * (2 * FF / 32), IT_FO = (FF / 64) * (DM / 32), IT_LAYER = IT_IN + IT_QUP + IT_KVUP + IT_BR + IT_OUT + IT_FI + IT_FO;
__device__ __forceinline__ void convert_weights_item(ArgsP Ap, int it, LAS float* scr, int lane) {
    const auto& A = *Ap;
    const int l = it / IT_LAYER; int r = it % IT_LAYER;
    unsigned char* wl = A.ws + WS_W + (size_t)l * WL_SIZE;
    if (r < IT_IN) { const int nblk = NIN / 32; cvt_item(A.in[I_WIN] + (size_t)l * DM * NIN_SRC, DM, NIN_SRC, (bf16_t*)(wl + WL_IN), nullptr, scr, r / nblk, r % nblk, lane, [](int n) { return win_src(n); }); return; } r -= IT_IN;
    if (r < IT_QUP) { const int nblk = 768 / 32; cvt_item(A.in[I_MWQ] + (size_t)l * 512 * 768, 512, 768, (bf16_t*)(wl + WL_UP), A.in[I_MQN] + l * 512, scr, r / nblk, r % nblk, lane,
        [](int n) { return n < 512 ? (n >> 7) * 192 + (n & 127) : ((n - 512) >> 6) * 192 + 128 + L64((n - 512) & 63); }); return; } r -= IT_QUP;
    if (r < IT_KVUP) { const int nblk = 1024 / 32; cvt_item(A.in[I_MWKV] + (size_t)l * 512 * 1024, 512, 1024, (bf16_t*)(wl + WL_UP) + (size_t)768 * 512, A.in[I_MKVN] + l * 512, scr, r / nblk, r % nblk, lane,
        [](int n) { return n < 512 ? (n >> 7) * 256 + (n & 127) : ((n - 512) >> 7) * 256 + 128 + ((n - 512) & 127); }); return; } r -= IT_KVUP;
    if (r < IT_BR) { const int per = IT_BR / 4, m = r / per, rr = r % per, nblk = DM / 32;
        cvt_item(A.in[I_WBR] + ((size_t)l * 4 + m) * 512 * DM, 512, DM, (bf16_t*)(wl + WL_BR) + (size_t)m * DM * 512, nullptr, scr, rr / nblk, rr % nblk, lane, [](int n) { return n; }); return; } r -= IT_BR;
    if (r < IT_OUT) { const int nblk = DM / 32; cvt_item(A.in[I_WOUT] + (size_t)l * DM * DM, DM, DM, (bf16_t*)(wl + WL_OUT), nullptr, scr, r / nblk, r % nblk, lane, [](int n) { return n; }); return; } r -= IT_OUT;
    if (r < IT_FI) { const int nblk = 2 * FF / 32; cvt_item(A.in[I_WFI] + (size_t)l * DM * 2 * FF, DM, 2 * FF, (bf16_t*)(wl + WL_FI), nullptr, scr, r / nblk, r % nblk, lane,
        [](int n) { const int t = n >> 8, w = n & 255; return w < 128 ? t * 128 + w : FF + t * 128 + (w - 128); }); return; } r -= IT_FI;
    { const int nblk = DM / 32; cvt_item(A.in[I_WFO] + (size_t)l * FF * DM, FF, DM, (bf16_t*)(wl + WL_FO), nullptr, scr, r / nblk, r % nblk, lane, [](int n) { return n; }); }
}
__device__ __forceinline__ void ada_unit(ArgsP Ap, int unit, LAS unsigned char* lds, int tid) {
    const auto& A = *Ap;
    LAS float* sl = (LAS float*)lds;
    LAS float* red = (LAS float*)(lds + 40960);
    const int l = unit / 48, cb = unit % 48, wid = tid >> 6, lane = tid & 63;
    for (int i = tid; i < 5 * DM; i += 512) { const int r = i / DM, k = i % DM; const float v = r < 4 ? A.in[I_C][r * DM + k] : A.in[I_CCTX][k]; sl[i] = v / (1.0f + __expf(-v)); }
    __syncthreads();
    const float* W = A.in[I_WADA] + (size_t)l * DM * (6 * DM) + cb * 256 + lane * 4;
    f32x4 acc[5];
#pragma unroll
    for (int r = 0; r < 5; ++r) acc[r] = (f32x4){0.f, 0.f, 0.f, 0.f};
    const int kbeg = wid * 256;
    for (int k = kbeg; k < kbeg + 256; k += 8) {
        f32x4 w[8];
#pragma unroll
        for (int j = 0; j < 8; ++j) w[j] = *(const f32x4*)(W + (size_t)(k + j) * (6 * DM));
#pragma unroll
        for (int j = 0; j < 8; ++j)
#pragma unroll
            for (int r = 0; r < 5; ++r) { const float s = sl[r * DM + k + j]; acc[r] += w[j] * s; }
    }
#pragma unroll
    for (int r = 0; r < 5; ++r) *(LAS f32x4*)(red + (wid * 5 + r) * 256 + lane * 4) = acc[r];
    __syncthreads();
    for (int i = tid; i < 5 * 256; i += 512) { const int r = i / 256, c = i % 256; float s = 0.f;
#pragma unroll
        for (int w = 0; w < 8; ++w) s += red[(w * 5 + r) * 256 + c];
        const int col = cb * 256 + c;
        ((float*)(A.ws + WS_ADA))[((size_t)l * 5 + r) * (6 * DM) + col] = s + A.in[I_BADA][(size_t)l * 6 * DM + col]; }
    __syncthreads();
}
__device__ __forceinline__ void ln_row(const float* src, float* xdst, bf16_t* hdst, const float* gam, const float* bet, const float* sc, const float* sh, int lane_, size_t slab = 0) {
    int lane = lane_; asm volatile("" : "+v"(lane));
    f32x4 v[8]; float s = 0.f;
#pragma unroll
    for (int j = 0; j < 8; ++j) { const float* p = src + 256 * j + 4 * lane; v[j] = *(const f32x4*)p;
        if (slab) v[j] = (v[j] + *(const f32x4*)(p + slab)) + (*(const f32x4*)(p + 2 * slab) + *(const f32x4*)(p + 3 * slab));
        s += (v[j][0] + v[j][1]) + (v[j][2] + v[j][3]); }
    const float mean = wave_sum(s) * (1.0f / DM); float q = 0.f;
#pragma unroll
    for (int j = 0; j < 8; ++j) { v[j] = v[j] - mean; q += (v[j][0] * v[j][0] + v[j][1] * v[j][1]) + (v[j][2] * v[j][2] + v[j][3] * v[j][3]); }
    const float rstd = 1.0f / sqrtf(wave_sum(q) * (1.0f / DM) + NORM_EPS);
#pragma unroll
    for (int j = 0; j < 8; ++j) { const int c = 256 * j + 4 * lane; f32x4 y = v[j] * rstd;
        if (gam) y = y * *(const f32x4*)(gam + c) + *(const f32x4*)(bet + c);
        *(f32x4*)(xdst + c) = y;
        if (hdst) { const f32x4 h = y * (*(const f32x4*)(sc + c) + 1.0f) + *(const f32x4*)(sh + c); u32x2 w; w.x = cvt_pk_bf16(h[0], h[1]); w.y = cvt_pk_bf16(h[2], h[3]); *(u32x2*)(hdst + c) = w; } }
}

__device__ __forceinline__ ArgsP args_ptr() { ArgsP p = (ArgsP)__builtin_amdgcn_kernarg_segment_ptr(); asm volatile("" : "+s"(p)); return p; }
#define WSP(T, off) ((T*)(ws + (off)))
#define PH_ENTER() ArgsP ap = args_ptr(); unsigned char* ws = ap->ws; int Gp = (int)gridDim.x, bxp = (int)blockIdx.x; asm volatile("" : "+s"(Gp), "+s"(bxp)); (void)Gp; (void)bxp


#define TAIL_CONVERT(nunits, i0, i1) do { if (l + 1 < DEPTH) { const int rem_ = (nunits) % Gp; if (rem_ != 0 && bxp >= rem_) { const int nw_ = (Gp - rem_) * 8, w_ = (bxp - rem_) * 8 + wid; \
        LAS float* scr_ = (LAS float*)(lds + wid * 16384); int ln_ = threadIdx.x & 63; asm volatile("" : "+v"(ln_)); \
        for (int it_ = (i0) + w_; it_ < (i1); it_ += nw_) convert_weights_item(ap, (l + 1) * IT_LAYER + it_, scr_, ln_); } } } while (0)
__global__ void __launch_bounds__(512, 2) mk_fwd(Args Aarg) {
    extern __shared__ __attribute__((aligned(16))) unsigned char lds_raw[];
    LAS unsigned char* lds = (LAS unsigned char*)lds_raw;
    const int tid = threadIdx.x, lane = tid & 63, wid = __builtin_amdgcn_readfirstlane(tid >> 6);
    const int G = gridDim.x, bx = blockIdx.x;
    volatile LAS unsigned* MISC = (volatile LAS unsigned*)(lds + LDSCTL_OFF);
    for (int u = tid; u < 256; u += 512) ((LAS unsigned*)(lds + LDSCTL_OFF))[u] = 0u;
    __syncthreads();
    XcdBarrier bar; bar.bar = nullptr; bar.x = 0; bar.st = nullptr;
    if (MK_N_LAUNCHES == 1) bar = xcd_barrier_post((unsigned*)(Aarg.ws + WS_CTL) + CW_BAR, MISC + 8);
    const int lo = Aarg.ph_lo, hi = Aarg.ph_hi;
#ifndef PHMASK
#define PHMASK 0xFFFFFFFFu
#endif
#define IN(k) (lo <= (k) && (k) < hi)
#define PHON(b) ((PHMASK >> (b)) & 1u)
#ifndef PROBE_DUP
#define PROBE_DUP 0u
#endif
#define NREP(b) (1 + (int)((PROBE_DUP >> (b)) & 1u))
#define SEAM(k) do { if (MK_N_LAUNCHES == 1 && (k) + 1 < hi) xcd_barrier(bar); } while (0)
    const int gw = bx * 8 + wid, NGW = G * 8;

    if (PHON(0) && IN(0)) {
_Pragma("unroll") for (int rep_ = 0; rep_ < NREP(0); ++rep_) {
        PH_ENTER();
        for (int u = bx; u < DEPTH * 48; u += G) ada_unit(ap, u, lds, tid);
        for (int i = bx * 512 + tid; i < SEQ * 96; i += G * 512) {
            const int t = i / 96, e = i % 96;
            if (e < 64) { const int ax = e >> 5, f = e & 31; const float pos = ax ? (float)(t & 63) : (float)(t >> 6); const float ang = pos * powf(10000.0f, -(float)f / 32.0f);
                WSP(f32x2, WS_T128)[(size_t)t * 64 + e] = (f32x2){cosf(ang), sinf(ang)}; }
            else { const int e2 = e - 64, ax = e2 >> 4, f = e2 & 15; const float pos = ax ? (float)(t & 63) : (float)(t >> 6); const float ang = pos * powf(10000.0f, -(float)f / 16.0f);
                WSP(f32x2, WS_T64)[(size_t)t * 32 + e2] = (f32x2){cosf(ang), sinf(ang)}; }
        }
        if (bx == 0 && wid < DEPTH) { const float* cl = ap->in[I_CLAM] + wid * 256; const float s1 = wave_sum(cl[lane] * cl[64 + lane]), s2 = wave_sum(cl[128 + lane] * cl[192 + lane]);
            if (lane == 0) WSP(float, WS_LAM)[wid] = expf(s1) - expf(s2) + (0.8f - 0.6f * expf(-0.3f * (float)wid)); }
        { LAS float* scr = (LAS float*)(lds + wid * 16384);
          for (int it = gw; it < IT_LAYER; it += NGW) convert_weights_item(ap, it, scr, lane); }
        __syncthreads();
        }
            SEAM(0);
    }
    if (PHON(1) && IN(1)) {
        PH_ENTER(); const float* xin = ap->in[I_X]; const float* cin = ap->in[I_CTX];
        for (int row = gw; row < MT; row += NGW) {
            const float* src = row < ML ? xin + (size_t)row * DM : cin + (size_t)(row - ML) * DM;
            const float* ad = WSP(float, WS_ADA) + (size_t)(row < ML ? (row >> 11) : 4) * (6 * DM);
            ln_row(src, WSP(float, WS_X) + (size_t)row * DM, WSP(bf16_t, WS_HB) + (size_t)row * DM, nullptr, nullptr, ad + 1 * DM, ad + 0 * DM, lane);
        }
        SEAM(1);
    }
    for (int l = 0; l < DEPTH; ++l) {
        const int p0 = NPH_PRO + l * NPH_LAYER;
        if (hi <= p0 || lo >= p0 + NPH_LAYER) continue;
        const bool lastl = (l == DEPTH - 1);
        const int nMpost = lastl ? 32 : 36;
        if (PHON(2) && IN(p0 + 0)) {
_Pragma("unroll") for (int rep_ = 0; rep_ < NREP(2); ++rep_) {
            PH_ENTER();
            pg8::Gemm g{WSP(bf16_t, WS_HB), WSP(const bf16_t, WS_W + (size_t)l * WL_SIZE + WL_IN), DM, DM, DM}; pg8::Order<0> S; S.init(36, NIN / 256, Gp, bxp, DM, DM, DM);
            pg8::EpiIn E{WSP(bf16_t, WS_ACT), WSP(bf16_t, WS_G), WSP(bf16_t, WS_DQKV), WSP(float, WS_SSQ), WSP(const f32x4, WS_T128), WSP(const f32x4, WS_T64), ap->in[I_AQKN] + l * 256, (LAS float*)(lds + XCH_OFF)};
            pg8::gemm_phase(lds, g, S, E);
            TAIL_CONVERT(36 * (NIN / 256), 0, IT_LAYER / 2);
            }
            SEAM(p0 + 0);
        }
        if (PHON(3) && IN(p0 + 1)) {
_Pragma("unroll") for (int rep_ = 0; rep_ < NREP(3); ++rep_) {
            PH_ENTER();
            pg8::Gemm g{WSP(bf16_t, WS_DQKV), WSP(const bf16_t, WS_W + (size_t)l * WL_SIZE + WL_UP), 512, 512, 512}; pg8::Order<2> S; S.init(36, 7, Gp, bxp, 512, 512, 512);
            pg8::EpiUp E{WSP(bf16_t, WS_ACT), WSP(float, WS_SSQ), WSP(const f32x4, WS_T64)};
            pg8::gemm_phase(lds, g, S, E);
            }
            SEAM(p0 + 1);
        }
        if (PHON(4) && IN(p0 + 2)) {
_Pragma("unroll") for (int rep_ = 0; rep_ < NREP(4); ++rep_) {
            PH_ENTER();
            unsigned* qhead = WSP(unsigned, WS_CTL) + CW_QUEUE + 64 * l + 32 * rep_;
            bf16_t* ACT = WSP(bf16_t, WS_ACT); bf16_t* OUTS = WSP(bf16_t, WS_OUTS);
            const float lam = WSP(float, WS_LAM)[l], omli = 1.0f - (0.8f - 0.6f * expf(-0.3f * (float)l));
#define ATT_FETCH() do { if (tid == 0) MISC[16] = __hip_atomic_fetch_add(qhead, 1u, __ATOMIC_RELAXED, __HIP_MEMORY_SCOPE_AGENT); __syncthreads(); L = (int)MISC[16]; __syncthreads(); } while (0)
#define ATT_DECODE(base) const int r_ = L - (base); const bool isctx = r_ >= 128; const int b = isctx ? ((r_ - 128) >> 2) : (r_ >> 5), h = isctx ? (r_ & 3) : ((r_ >> 3) & 3), qb = isctx ? 0 : (r_ & 7); \
                const int qrow0 = isctx ? (ML + b * CTXL) : (b * SEQ + qb * 256); att::UnitArgs ua; ua.crow0 = ML + b * CTXL; ua.ntc = 4; ua.lrow0 = b * SEQ; ua.nt = isctx ? 4 : 36; ua.dpos = 0; ua.sink = 0.f; \
                ua.ldo = DM; ua.scr = WSP(float, WS_O1) + (size_t)qrow0 * 512 + h * 128; ua.lam = lam; ua.omli = omli; ua.gsub = ap->in[I_CSUBLN] + l * 128; ua.ldq = LDACT; ua.ldk = LDACT; ua.ldv = LDACT;
            int L; ATT_FETCH();
#ifndef ATTMASK
#define ATTMASK 15
#endif
            while ((ATTMASK & 1) && L < 144) {
                if (!(lastl && L >= 128)) { ATT_DECODE(0)
                    ua.Vb = ACT + C_CV + h * 128; ua.out = OUTS + (size_t)qrow0 * DM + 1024 + h * 128;
                    ua.Qb = ACT + (size_t)qrow0 * LDACT + C_CQ + h * 128; ua.Kb = ACT + C_CK + h * 128;
                    att::attn_unit<64, false, false, 1>(ua, (char*)lds_raw);
                    ua.Qb += 64; ua.Kb += 64;
                    att::attn_unit<64, false, false, 2>(ua, (char*)lds_raw); }
                ATT_FETCH();
            }
            while ((ATTMASK & 2) && L < 288) {
                if (!(lastl && L >= 272)) { ATT_DECODE(144)
                    ua.Qb = ACT + (size_t)qrow0 * LDACT + C_DQ + h * 192; ua.Kb = ACT + C_DK + h * 192; ua.Vb = ACT + C_DV + h * 128; ua.out = OUTS + (size_t)qrow0 * DM + 1536 + h * 128;
                    att::attn_unit<192, false, false, 0>(ua, (char*)lds_raw); }
                ATT_FETCH();
            }
            while ((ATTMASK & 4) && L < 432) {
                if (!(lastl && L >= 416)) { ATT_DECODE(288)
                    ua.Qb = ACT + (size_t)qrow0 * LDACT + C_AQ + h * 128; ua.Kb = ACT + C_AK + (h >> 1) * 128; ua.Vb = ACT + C_AV + (h >> 1) * 128; ua.out = OUTS + (size_t)qrow0 * DM + 0 + h * 128;
                    att::attn_unit<128, false, false, 0>(ua, (char*)lds_raw); }
                ATT_FETCH();
            }
            while ((ATTMASK & 8) && L < 576) {
                if (!(lastl && L >= 560)) { ATT_DECODE(432)
                    ua.Qb = ACT + (size_t)qrow0 * LDACT + C_BQ + h * 128; ua.Kb = ACT + C_BK + (h >> 1) * 128; ua.Vb = ACT + C_BV + (h >> 1) * 128; ua.out = OUTS + (size_t)qrow0 * DM + 512 + h * 128;
                    ua.sink = ap->in[I_BSINK][l * 4 + h];
                    if (!isctx) { const int t0 = (4 * qb - 2) < 0 ? 0 : (4 * qb - 2), t1 = (4 * qb + 5) > 31 ? 31 : (4 * qb + 5);
                        ua.lrow0 = b * SEQ + 64 * t0; ua.nt = 4 + (t1 - t0 + 1); ua.dpos = 64 * t0 - 256 * qb; }
                    att::attn_unit<128, true, true, 0>(ua, (char*)lds_raw); }
                ATT_FETCH();
            }
#undef ATT_FETCH
#undef ATT_DECODE
            }
            SEAM(p0 + 2);
        }
        if (PHON(5) && IN(p0 + 3)) {
            PH_ENTER();
            pg8::Gemm g{WSP(bf16_t, WS_OUTS), WSP(const bf16_t, WS_W + (size_t)l * WL_SIZE + WL_BR), 512, DM, 512}; pg8::Order<1> S; S.init(nMpost, 32, Gp, bxp, DM, 512, 512);
            pg8::EpiMerge E{WSP(bf16_t, WS_G)};
            pg8::gemm_phase(lds, g, S, E);
            SEAM(p0 + 3);
        }
        if (PHON(6) && IN(p0 + 4)) {
_Pragma("unroll") for (int rep_ = 0; rep_ < NREP(6); ++rep_) {
            PH_ENTER(); const bf16_t* GT = WSP(bf16_t, WS_G); bf16_t* Y = WSP(bf16_t, WS_Y);
            const int nchunk = nMpost * 256 * (DM / 8); int t_ = threadIdx.x; asm volatile("" : "+v"(t_));
            for (int i = bx * 512 + t_; i < nchunk; i += G * 512) { const int row = i >> 8, c8 = (i & 255) * 8; const bf16_t* zp = GT + (size_t)row * 8192 + c8;
                const u32x4 z0 = *(const u32x4*)zp, z1 = *(const u32x4*)(zp + 2048), z2 = *(const u32x4*)(zp + 4096), z3 = *(const u32x4*)(zp + 6144); u32x4 w;
#define S4(f) ((bf_lo(z0.f) + bf_lo(z1.f)) + (bf_lo(z2.f) + bf_lo(z3.f))), ((bf_hi(z0.f) + bf_hi(z1.f)) + (bf_hi(z2.f) + bf_hi(z3.f)))
                w.x = cvt_pk_bf16(S4(x)); w.y = cvt_pk_bf16(S4(y)); w.z = cvt_pk_bf16(S4(z)); w.w = cvt_pk_bf16(S4(w));
#undef S4
                *(u32x4*)(Y + (size_t)row * DM + c8) = w; }
            }
            SEAM(p0 + 4);
        }
        if (PHON(7) && IN(p0 + 5)) {
_Pragma("unroll") for (int rep_ = 0; rep_ < NREP(7); ++rep_) {
            PH_ENTER();
            pg8::Gemm g{WSP(bf16_t, WS_Y), WSP(const bf16_t, WS_W + (size_t)l * WL_SIZE + WL_OUT), DM, DM, DM}; pg8::Order<3> S; S.init(32, 8, Gp, bxp, DM, DM, DM, lastl ? 0 : 128);
            pg8::EpiRes E{WSP(float, WS_X), WSP(float, WS_PRE), WSP(float, WS_ADA) + (size_t)l * 5 * (6 * DM) + 2 * DM, WSP(float, WS_PART)};
            pg8::gemm_phase(lds, g, S, E);
            }
            SEAM(p0 + 5);
        }
        if (PHON(8) && IN(p0 + 6)) {
_Pragma("unroll") for (int rep_ = 0; rep_ < NREP(8); ++rep_) {
            PH_ENTER(); const float* gam = ap->in[I_LMG] + l * DM; const float* bet = ap->in[I_LMB] + l * DM;
            for (int row = gw; row < nMpost * 256; row += NGW) { const float* ad = WSP(float, WS_ADA) + (size_t)l * 5 * (6 * DM) + (size_t)(row < ML ? (row >> 11) : 4) * (6 * DM);
                const bool cx = row >= ML; ln_row((cx ? WSP(float, WS_PART) - (size_t)ML * DM : WSP(float, WS_PRE)) + (size_t)row * DM, WSP(float, WS_X) + (size_t)row * DM, WSP(bf16_t, WS_HB) + (size_t)row * DM, gam, bet, ad + 4 * DM, ad + 3 * DM, lane, cx ? (size_t)MC * DM : 0); }
            }
            SEAM(p0 + 6);
        }
        if (PHON(9) && IN(p0 + 7)) {
_Pragma("unroll") for (int rep_ = 0; rep_ < NREP(9); ++rep_) {
            PH_ENTER();
            pg8::Gemm g{WSP(bf16_t, WS_HB), WSP(const bf16_t, WS_W + (size_t)l * WL_SIZE + WL_FI), DM, DM, DM}; pg8::Order<0> S; S.init(nMpost, 2 * FF / 256, Gp, bxp, DM, DM, DM);
            pg8::EpiSwi E{WSP(bf16_t, WS_FH)};
            pg8::gemm_phase(lds, g, S, E);
            TAIL_CONVERT(nMpost * (2 * FF / 256), IT_LAYER / 2, IT_LAYER);
            }
            SEAM(p0 + 7);
        }
        if (PHON(10) && IN(p0 + 8)) {
_Pragma("unroll") for (int rep_ = 0; rep_ < NREP(10); ++rep_) {
            PH_ENTER();
            pg8::Gemm g{WSP(bf16_t, WS_FH), WSP(const bf16_t, WS_W + (size_t)l * WL_SIZE + WL_FO), FF, FF, FF}; pg8::Order<3> S; S.init(32, 8, Gp, bxp, FF, FF, FF, lastl ? 0 : 128);
            pg8::EpiRes E{WSP(float, WS_X), WSP(float, WS_PRE), WSP(float, WS_ADA) + (size_t)l * 5 * (6 * DM) + 5 * DM, WSP(float, WS_PART)};
            pg8::gemm_phase(lds, g, S, E);
            }
            SEAM(p0 + 8);
        }
        if (PHON(11) && IN(p0 + 9)) {
_Pragma("unroll") for (int rep_ = 0; rep_ < NREP(11); ++rep_) {
            PH_ENTER(); const float* gam = ap->in[I_LFG] + l * DM; const float* bet = ap->in[I_LFB] + l * DM;
            float* xo = lastl ? ap->out : WSP(float, WS_X);
            const float* adaN = WSP(float, WS_ADA) + (size_t)(lastl ? l : l + 1) * 5 * (6 * DM);
            for (int row = gw; row < nMpost * 256; row += NGW) { const float* ad = adaN + (size_t)(row < ML ? (row >> 11) : 4) * (6 * DM);
                const bool cx = row >= ML; ln_row((cx ? WSP(float, WS_PART) - (size_t)ML * DM : WSP(float, WS_PRE)) + (size_t)row * DM, xo + (size_t)row * DM, lastl ? nullptr : WSP(bf16_t, WS_HB) + (size_t)row * DM, gam, bet, ad + 1 * DM, ad + 0 * DM, lane, cx ? (size_t)MC * DM : 0); }
            }
            SEAM(p0 + 9);
        }
    }
#undef IN
#undef SEAM
}


#ifndef MK_DIAG
#define MK_DIAG 0
#endif
#if MK_DIAG
struct Reg { size_t off, bytes; };
__global__ void k_cksum(const unsigned char* ws, size_t off, size_t bytes, unsigned long long* slot) {
    const uint4* p = (const uint4*)(ws + off); const size_t n = bytes / 16; unsigned long long s = 0;
    for (size_t i = (size_t)blockIdx.x * blockDim.x + threadIdx.x; i < n; i += (size_t)gridDim.x * blockDim.x) { const uint4 v = p[i]; s += (unsigned long long)v.x * 3u + (unsigned long long)v.y * 5u + (unsigned long long)v.z * 7u + (unsigned long long)v.w * 11u + (i & 0xffff); }
    for (int o = 32; o >= 1; o >>= 1) s += __shfl_xor(s, o);
    if ((threadIdx.x & 63) == 0) atomicAdd(slot, s);
}
__global__ void k_diag_out(const unsigned long long* tab, int nph, float* out, int n) {
    int code = 0; for (int p = nph - 1; p >= 0; --p) if (tab[p] != tab[64 + p]) code = p + 1;
    for (int i = blockIdx.x * blockDim.x + threadIdx.x; i < n; i += gridDim.x * blockDim.x) out[i] = (i == 0) ? 1.0e6f * (float)code : 0.0f;
}
#endif
extern "C" void kernel_launch(void* const* d_in, const int* in_sizes, int n_in, void* d_out, int out_size, void* d_ws, size_t ws_size, hipStream_t stream) {
    static int grid = 0;
    if (grid == 0) {
        if (n_in != 23 || out_size != ML * DM || ws_size < WS_END) { fprintf(stderr, "kernel_launch: shape mismatch (n_in %d out %d ws %zu need %zu)\n", n_in, out_size, ws_size, (size_t)WS_END); grid = -1; return; }
        int dev = 0, cus = 0, per_cu = 0;
        if (hipGetDevice(&dev) != hipSuccess || hipDeviceGetAttribute(&cus, hipDeviceAttributeMultiprocessorCount, dev) != hipSuccess) { grid = -1; return; }
        if (hipFuncSetAttribute((const void*)mk_fwd, hipFuncAttributeMaxDynamicSharedMemorySize, LDS_BYTES) != hipSuccess) { fprintf(stderr, "kernel_launch: hipFuncSetAttribute failed\n"); grid = -1; return; }
        if (hipOccupancyMaxActiveBlocksPerMultiprocessor(&per_cu, (const void*)mk_fwd, 512, LDS_BYTES) != hipSuccess || per_cu < 1) { fprintf(stderr, "kernel_launch: occupancy query says %d\n", per_cu); }
        (void)hipGetLastError();
        grid = cus;
    }
    if (grid < 0) return;
    if (hipMemsetAsync((char*)d_ws + WS_CTL, 0, CTL_ZERO_BYTES, stream) != hipSuccess) return;
    Args a{};
    for (int i = 0; i < 23; ++i) a.in[i] = (const float*)d_in[i];
    a.out = (float*)d_out; a.ws = (unsigned char*)d_ws;
#if MK_DIAG
    {   unsigned long long* tab = (unsigned long long*)((char*)d_ws + WS_CTL + 512 * 1024);
        const int NP = DIAG_NP;
        for (int run = 0; run < 2; ++run) for (int p = 0; p < NP; ++p) {
            if (run == 1 && p == 0) hipMemsetAsync((char*)d_ws + WS_CTL, 0, 256 * 1024, stream);
            a.ph_lo = p; a.ph_hi = p + 1; hipLaunchKernelGGL(mk_fwd, dim3(grid), dim3(512), LDS_BYTES, stream, a);
            Reg regs[4]; int nr = 0; const int q = (p - 2) % 10;
            if (p == 0) { regs[nr++] = {WS_ADA, (size_t)DEPTH * 5 * 6 * DM * 4}; regs[nr++] = {WS_T128, 3 * MiB / 2}; regs[nr++] = {WS_LAM, 16}; regs[nr++] = {WS_W, DEPTH * WL_SIZE}; }
            else if (p == 1 || q == 6 || q == 9) { regs[nr++] = {WS_X, SZ_F32ROWS}; regs[nr++] = {WS_HB, SZ_BF16ROWS}; }
            else if (q == 0) { regs[nr++] = {WS_G, (size_t)MT * 8192 * 2}; regs[nr++] = {WS_DQKV, (size_t)2 * MT * 512 * 2}; regs[nr++] = {WS_SSQ, (size_t)MT * 16 * 4}; }
            else if (q == 1) { regs[nr++] = {WS_ACT, (size_t)MT * LDACT * 2}; }
            else if (q == 2) { regs[nr++] = {WS_OUTS, SZ_BF16ROWS}; regs[nr++] = {WS_O1, (size_t)MT * 512 * 4}; }
            else if (q == 3) { regs[nr++] = {WS_G, (size_t)MT * 8192 * 2}; }
            else if (q == 4) { regs[nr++] = {WS_Y, SZ_BF16ROWS}; }
            else if (q == 5 || q == 8) { regs[nr++] = {WS_PRE, SZ_F32ROWS}; }
            else if (q == 7) { regs[nr++] = {WS_FH, (size_t)MT * FF * 2}; }
            for (int r = 0; r < nr; ++r) hipLaunchKernelGGL(k_cksum, dim3(1024), dim3(256), 0, stream, (const unsigned char*)d_ws, regs[r].off, regs[r].bytes, tab + run * 64 + p);
        }
        hipLaunchKernelGGL(k_diag_out, dim3(1024), dim3(256), 0, stream, (const unsigned long long*)tab, NP, (float*)d_out, out_size);
        return;
    }
#endif
    if (MK_N_LAUNCHES == 1) { a.ph_lo = 0; a.ph_hi = NPH_TOTAL; hipLaunchKernelGGL(mk_fwd, dim3(grid), dim3(512), LDS_BYTES, stream, a); }
    else for (int p = 0; p < NPH_TOTAL; ++p) { a.ph_lo = p; a.ph_hi = p + 1; hipLaunchKernelGGL(mk_fwd, dim3(grid), dim3(512), LDS_BYTES, stream, a); }
    const hipError_t le = hipPeekAtLastError();
    if (le != hipSuccess) fprintf(stderr, "kernel_launch: launch failed: %s\n", hipGetErrorName(le));
}
```

```cpp
#include <hip/hip_runtime.h>
#include <cstdio>
#include <cstdint>

#ifndef MK_N_LAUNCHES
#define MK_N_LAUNCHES 1
#endif

#define LAS __attribute__((address_space(3)))
#define GAS __attribute__((address_space(1)))
typedef unsigned short bf16_t;
typedef short bf16x8 __attribute__((ext_vector_type(8)));
typedef short s16x4 __attribute__((ext_vector_type(4)));
typedef float f32x2 __attribute__((ext_vector_type(2)));
typedef float f32x4 __attribute__((ext_vector_type(4)));
typedef float f32x16 __attribute__((ext_vector_type(16)));
typedef unsigned u32x2 __attribute__((ext_vector_type(2)));
typedef unsigned u32x4 __attribute__((ext_vector_type(4)));

constexpr int DM = 2048, NBATCH = 4, SEQ = 2048, DEPTH = 4, CTXL = 256;
constexpr int ML = NBATCH * SEQ, MC = NBATCH * CTXL, MT = ML + MC;
constexpr int NIN_SRC = 12864, NIN = 13056;
constexpr int FF = 5632;
constexpr float NORM_EPS = 1e-6f;
constexpr float ALPHA = 1.681792830507429f;
constexpr int LDACT = 5632;
constexpr int C_AQ = 0, C_AK = 512, C_AV = 768, C_BQ = 1024, C_BK = 1536, C_BV = 1792, C_CQ = 2048, C_CK = 2560, C_CV = 3072, C_DQ = 3584, C_DK = 4352, C_DV = 5120;

constexpr size_t MiB = 1u << 20;
constexpr size_t WS_CTL = 0, CTL_ZERO_BYTES = 1 * MiB;
constexpr size_t WS_ADA = 1 * MiB;
constexpr size_t WS_T128 = 2 * MiB;
constexpr size_t WS_T64 = 3 * MiB;
constexpr size_t WS_LAM = 3 * MiB + 512 * 1024;
constexpr size_t WS_SSQ = 4 * MiB;
constexpr size_t WS_X = 8 * MiB;
constexpr size_t SZ_F32ROWS = (size_t)MT * DM * 4;
constexpr size_t WS_PRE = WS_X + SZ_F32ROWS;
constexpr size_t WS_HB = WS_PRE + SZ_F32ROWS;
constexpr size_t SZ_BF16ROWS = (size_t)MT * DM * 2;
constexpr size_t WS_ACT = WS_HB + SZ_BF16ROWS;
constexpr size_t WS_DQKV = WS_ACT + (size_t)MT * LDACT * 2;
constexpr size_t WS_G = WS_DQKV + (size_t)2 * MT * 512 * 2;
constexpr size_t WS_OUTS = WS_G + (size_t)MT * 8192 * 2;
constexpr size_t WS_Y = WS_OUTS + SZ_BF16ROWS;
constexpr size_t WS_FH = WS_Y + SZ_BF16ROWS;
constexpr size_t WS_O1 = WS_FH + (size_t)MT * FF * 2;
constexpr size_t WS_W = WS_O1 + (size_t)MT * 512 * 4;
constexpr size_t WL_IN = 0, WL_UP = WL_IN + (size_t)NIN * DM * 2, WL_BR = WL_UP + (size_t)1792 * 512 * 2, WL_OUT = WL_BR + (size_t)8192 * 512 * 2,
                 WL_FI = WL_OUT + (size_t)DM * DM * 2, WL_FO = WL_FI + (size_t)2 * FF * DM * 2, WL_SIZE = WL_FO + (size_t)DM * FF * 2;
constexpr size_t WS_PART = WS_W + DEPTH * WL_SIZE;
constexpr size_t WS_END = WS_PART + (size_t)4 * MC * DM * 4;
static_assert(WS_SSQ + (size_t)MT * 16 * 4 <= WS_X && WS_ADA + (size_t)DEPTH * 5 * 6 * DM * 4 <= WS_T128, "ws map");
constexpr int CW_BAR = 4096;
constexpr int CW_QUEUE = 16384;

constexpr int RING_BYTES = 131072, LDSCTL_OFF = RING_BYTES, XCH_OFF = LDSCTL_OFF + 1024, LDS_BYTES = 147456;
static_assert(XCH_OFF + 8192 <= LDS_BYTES, "LDS map");

typedef __bf16 bf16x2_t __attribute__((ext_vector_type(2)));
__device__ __forceinline__ unsigned cvt_pk_bf16(float lo, float hi) { bf16x2_t v = {(__bf16)lo, (__bf16)hi}; return __builtin_bit_cast(unsigned, v); }
__device__ __forceinline__ float bf_lo(unsigned w) { return __uint_as_float(w << 16); }
__device__ __forceinline__ float bf_hi(unsigned w) { return __uint_as_float(w & 0xffff0000u); }
__device__ __forceinline__ float fast_sigmoid(float x) { return __builtin_amdgcn_rcpf(1.0f + __builtin_amdgcn_exp2f(-1.4426950408889634f * x)); }
__device__ __forceinline__ float wave_sum(float v) {
#pragma unroll
    for (int o = 1; o < 64; o <<= 1) v += __shfl_xor(v, o);
    return v;
}
__host__ __device__ __forceinline__ int L128(int p) { const int i = p >> 1, odd = p & 1; return i + 32 * odd + (i >= 32 ? 32 : 0); }
__host__ __device__ __forceinline__ int L64(int p) { const int i = p >> 1, odd = p & 1; return i + 16 * odd + (i >= 16 ? 16 : 0); }
__host__ __device__ __forceinline__ int win_src(int c) {
    const int t = c >> 8, w = c & 255;
    if (t >= 19) return 4672 + (c - 19 * 256);
    switch (t) {
        case 0: case 1: { const int cc = c; return 0 + (cc >> 7) * 128 + L128(cc & 127); }
        case 2: return 512 + (w >> 7) * 128 + L128(w & 127);
        case 3: return 768 + w;
        case 4: case 5: { const int cc = c - 1024; return 1024 + (cc >> 7) * 128 + L128(cc & 127); }
        case 6: return 1536 + (w >> 7) * 128 + L128(w & 127);
        case 7: return 1792 + w;
        case 8: case 9: { const int cc = c - 2048; return 2048 + (cc >> 6) * 64 + L64(cc & 63); }
        case 10: case 11: { const int cc = c - 2560; return 2560 + (cc >> 6) * 64 + L64(cc & 63); }
        case 12: case 13: return 3072 + (c - 3072);
        case 14: case 15: return 3584 + (c - 3584);
        case 16: case 17: return 4096 + (c - 4096);
        default: return 4608 + L64(w & 63);
    }
}

namespace pg8 {
constexpr int BM = 256, BK = 64, HALF = 128, HTB = HALF * BK * 2, STAGE_BYTES = 8 * HTB, NXCD = 8, WGM = 8;
__host__ __device__ __forceinline__ int lds_byte(int r, int c) { const int st = (r >> 4) * 2 + (c >> 5), rr = r & 15, cc = c & 31, ob = rr * 64 + cc * 2; return st * 1024 + (ob ^ (((ob >> 9) & 1) << 5)); }
__host__ __device__ __forceinline__ void stage_rc(int b, int& R, int& C) { const int st = b / 1024, sb = b % 1024, swz = sb ^ (((sb >> 9) & 1) << 5); R = (st >> 1) * 16 + swz / 64; C = (st & 1) * 32 + (swz % 64) / 2; }
__host__ __device__ __forceinline__ int perm32(int rho) { const int n = rho >> 4, i = rho & 15; return 8 * (i >> 2) + 4 * n + (i & 3); }
struct Unit { int pm, pn, ks; };
struct Gemm { const bf16_t* A; const bf16_t* Bt; int K, lda, ldb; };
template <int AMODE  > struct Order {
    int nM, nN, nwg, G, c; int lda, ldb, nt_full, nsub;
    __device__ void init(int nM_, int nN_, int G_, int c_, int lda_, int ldb_, int K_, int nsub_ = 0) { nM = nM_; nN = nN_; nwg = nM * nN; G = G_; c = c_; lda = lda_; ldb = ldb_; nt_full = K_ / BK; nsub = nsub_; }
    __device__ bool next(int i, Unit& u) const {
        const long L = (long)i * G + c; u.ks = -1;
        if (L >= nwg) { if (AMODE == 4) { const int idx = (int)(L - nwg); if (idx < nsub) { const unsigned long long tbl = 2ull | (3ull << 5) | (6ull << 10) | (7ull << 15) | (10ull << 20) | (11ull << 25) | (12ull << 30) | (13ull << 35) | (16ull << 40) | (17ull << 45) | (18ull << 50);
                    u.pm = 32 + idx / 11; u.pn = (int)((tbl >> (5 * (idx % 11))) & 31ull); return true; } }
            if (AMODE == 3) { const int idx = (int)(L - nwg); if (idx < nsub) { const int t = idx >> 2; u.ks = idx & 3; u.pm = 32 + t / nN; u.pn = t % nN; return true; } } return false; }
        int wgid = (int)L; { const int q = nwg / NXCD, r = nwg % NXCD, xcd = wgid % NXCD, off = wgid / NXCD; wgid = (xcd < r ? xcd * (q + 1) : r * (q + 1) + (xcd - r) * q) + off; }
        const int nig = WGM * nN, gid = wgid / nig, fm = gid * WGM, gsz = (nM - fm) < WGM ? (nM - fm) : WGM;
        u.pm = fm + ((wgid % nig) % gsz); u.pn = (wgid % nig) / gsz; return true;
    }
    __device__ __forceinline__ int kt(const Unit& u) const { return (AMODE == 3 && u.ks >= 0) ? (nt_full >> 2) : nt_full; }
    __device__ __forceinline__ size_t a_off(const Unit& u) const {
        size_t o = (size_t)u.pm * BM * lda;
        if (AMODE == 1) o += (size_t)(u.pn >> 3) * 512;
        if (AMODE == 2) o += (u.pn >= 3) ? (size_t)MT * 512 : 0;
        if (AMODE == 3) o += (u.ks > 0) ? (size_t)u.ks * (nt_full >> 2) * BK : 0;
        return o;
    }
    __device__ __forceinline__ size_t b_off(const Unit& u) const { size_t o = (size_t)u.pn * BM * ldb; if (AMODE == 3) o += (u.ks > 0) ? (size_t)u.ks * (nt_full >> 2) * BK : 0; return o; }
};

template <class Epi, class Sched>
__device__ __forceinline__ void gemm_phase(LAS unsigned char* lds, const Gemm g, const Sched& S, const Epi& E) {
    int tid_ = threadIdx.x; asm volatile("" : "+v"(tid_));
    const int tid = tid_, wid = __builtin_amdgcn_readfirstlane(tid >> 6), lane = tid & 63, wr = wid >> 2, wc = wid & 3, fr = lane & 15, fq = lane >> 4;
    unsigned voffA[2], voffB[2];
#pragma unroll
    for (int i = 0; i < 2; ++i) { int R, C; stage_rc(tid * 16 + i * 8192, R, C); const int Rb = Epi::PERM ? ((R & ~31) + perm32(R & 31)) : R;
        voffA[i] = (unsigned)(R * g.lda + C) * 2u; voffB[i] = (unsigned)(Rb * g.ldb + C) * 2u; }
    const size_t kstep = (size_t)(BK * 2);
    const size_t hstepA = (size_t)HALF * g.lda * 2, hstepB = (size_t)HALF * g.ldb * 2;
    const unsigned ldsw = (unsigned)wid * 1024u;
    const int aoff = lds_byte(wr * 64 + fr, fq * 8), boff = lds_byte(wc * 32 + fr, fq * 8);
#define PG8_SA(b, h) (((b) * 2 + (h)) * HTB)
#define PG8_SB(b, h) ((4 + (b) * 2 + (h)) * HTB)
#define PG8_STAGE(bufoff, gbase, voff) do { _Pragma("unroll") for (int _i = 0; _i < 2; ++_i) \
        __builtin_amdgcn_global_load_lds((const unsigned*)((const char*)(gbase) + (voff)[_i]), (LAS unsigned*)(lds + (bufoff) + ldsw + _i * 8192), 16, 0, 0); } while (0)
#define PG8_LDA(dst, b, h) do { _Pragma("unroll") for (int m = 0; m < 4; ++m) _Pragma("unroll") for (int k = 0; k < 2; ++k) dst[m][k] = *(const LAS bf16x8*)(lds + PG8_SA(b, h) + aoff + m * 2048 + k * 1024); } while (0)
#define PG8_LDB(dst, b, h) do { _Pragma("unroll") for (int n = 0; n < 2; ++n) _Pragma("unroll") for (int k = 0; k < 2; ++k) dst[n][k] = *(const LAS bf16x8*)(lds + PG8_SB(b, h) + boff + n * 2048 + k * 1024); } while (0)
#define PG8_MMA(ai, bj, At, Bt) do { __builtin_amdgcn_s_setprio(1); _Pragma("unroll") for (int m = 0; m < 4; ++m) _Pragma("unroll") for (int n = 0; n < 2; ++n) _Pragma("unroll") for (int k = 0; k < 2; ++k) \
        acc[ai][bj][m][n] = __builtin_amdgcn_mfma_f32_16x16x32_bf16(Bt[n][k], At[m][k], acc[ai][bj][m][n], 0, 0, 0); __builtin_amdgcn_s_setprio(0); } while (0)
#define PG8_WAIT_V(n) asm volatile("s_waitcnt vmcnt(" #n ")" ::: "memory")
#define PG8_WAIT_L(n) asm volatile("s_waitcnt lgkmcnt(" #n ")" ::: "memory")
#define PG8_BAR __builtin_amdgcn_s_barrier()
#define PG8_SCHED __builtin_amdgcn_sched_barrier(0)
    Unit cur, nxt; int ui = 0;
    if (!S.next(0, cur)) return;
    f32x4 acc[2][2][4][2];
#pragma unroll
    for (int a = 0; a < 2; ++a)
#pragma unroll
        for (int b = 0; b < 2; ++b)
#pragma unroll
            for (int m = 0; m < 4; ++m)
#pragma unroll
                for (int n = 0; n < 2; ++n) acc[a][b][m][n] = (f32x4){0.f, 0.f, 0.f, 0.f};
    bf16x8 At[4][2], B0[2][2], B1[2][2];
    const char* cA = (const char*)g.A + S.a_off(cur) * 2; const char* cB = (const char*)g.Bt + S.b_off(cur) * 2;
    PG8_STAGE(PG8_SB(0, 0), cB, voffB); PG8_STAGE(PG8_SB(0, 1), cB + hstepB, voffB); PG8_STAGE(PG8_SA(0, 0), cA, voffA); PG8_STAGE(PG8_SA(0, 1), cA + hstepA, voffA);
    if (wr == 1) PG8_BAR;
    PG8_WAIT_V(2); PG8_BAR;
    PG8_STAGE(PG8_SB(1, 0), cB + kstep, voffB); PG8_STAGE(PG8_SA(1, 0), cA + kstep, voffA); PG8_STAGE(PG8_SB(1, 1), cB + hstepB + kstep, voffB);
    PG8_WAIT_V(6); PG8_BAR;
    for (;;) {
        const bool has_next = S.next(ui + 1, nxt); const int nt = S.kt(cur);
        const char* nA = has_next ? (const char*)g.A + S.a_off(nxt) * 2 : cA; const char* nB = has_next ? (const char*)g.Bt + S.b_off(nxt) * 2 : cB;
        for (int t = 0; t < nt; t += 2) {
            const bool last = (t == nt - 2);
            const char* a1 = cA + (size_t)(t + 1) * kstep;
            const char* a2 = last ? nA : cA + (size_t)(t + 2) * kstep; const char* b2 = last ? nB : cB + (size_t)(t + 2) * kstep;
            const char* a3 = a2 + kstep; const char* b3 = b2 + kstep;
            PG8_LDB(B0, 0, 0); PG8_LDB(B1, 0, 1); PG8_SCHED; PG8_LDA(At, 0, 0); PG8_STAGE(PG8_SA(1, 1), a1 + hstepA, voffA);
            PG8_WAIT_V(8); PG8_WAIT_L(0); PG8_BAR; PG8_MMA(0, 0, At, B0); PG8_MMA(0, 1, At, B1); PG8_BAR; PG8_SCHED;
            PG8_LDA(At, 0, 1); PG8_STAGE(PG8_SB(0, 0), b2, voffB); PG8_STAGE(PG8_SB(0, 1), b2 + hstepB, voffB); PG8_STAGE(PG8_SA(0, 0), a2, voffA);
            PG8_WAIT_V(8); PG8_WAIT_L(0); PG8_BAR; PG8_MMA(1, 0, At, B0); PG8_MMA(1, 1, At, B1); PG8_BAR; PG8_SCHED;
            PG8_LDB(B0, 1, 0); PG8_LDB(B1, 1, 1); PG8_SCHED; PG8_LDA(At, 1, 0); PG8_STAGE(PG8_SA(0, 1), a2 + hstepA, voffA);
            PG8_WAIT_V(8); PG8_WAIT_L(0); PG8_BAR; PG8_MMA(0, 0, At, B0); PG8_MMA(0, 1, At, B1); PG8_BAR; PG8_SCHED;
            PG8_LDA(At, 1, 1); PG8_STAGE(PG8_SB(1, 0), b3, voffB); PG8_STAGE(PG8_SB(1, 1), b3 + hstepB, voffB); PG8_STAGE(PG8_SA(1, 0), a3, voffA);
            PG8_WAIT_V(8); PG8_WAIT_L(0); PG8_BAR; PG8_MMA(1, 0, At, B0); PG8_MMA(1, 1, At, B1); PG8_BAR; PG8_SCHED;
        }
        if (wr == 0) PG8_BAR;
        E(acc, cur, wr, wc, fr, fq);
        if (!has_next) break;
#pragma unroll
        for (int a = 0; a < 2; ++a)
#pragma unroll
            for (int b = 0; b < 2; ++b)
#pragma unroll
                for (int m = 0; m < 4; ++m)
#pragma unroll
                    for (int n = 0; n < 2; ++n) acc[a][b][m][n] = (f32x4){0.f, 0.f, 0.f, 0.f};
        cur = nxt; cA = nA; cB = nB; ++ui;
        if (wr == 1) PG8_BAR;
    }
    PG8_WAIT_V(0);
    PG8_BAR;
#undef PG8_SA
#undef PG8_SB
#undef PG8_STAGE
#undef PG8_LDA
#undef PG8_LDB
#undef PG8_MMA
#undef PG8_WAIT_V
#undef PG8_WAIT_L
#undef PG8_BAR
#undef PG8_SCHED
}

struct EpiIn {
    static constexpr bool PERM = true;
    bf16_t* act; bf16_t* gates; bf16_t* dqkv; float* ssq; const f32x4* t128; const f32x4* t64; const float* qkn; LAS float* xch;
    __device__ __forceinline__ void operator()(const f32x4 (&acc)[2][2][4][2], const Unit& u, int wr, int wc, int fr, int fq) const {
        const int pn = u.pn, row0 = u.pm * BM + wr * 64 + fr, tc0 = wc * 32 + 8 * fq;
        if (pn >= 19) {
#pragma unroll
            for (int ai = 0; ai < 2; ++ai)
#pragma unroll
                for (int m = 0; m < 4; ++m) { bf16_t* rowp = gates + (size_t)(row0 + ai * HALF + m * 16) * 8192 + (pn - 19) * 256 + tc0;
#pragma unroll
                    for (int bj = 0; bj < 2; ++bj) { const f32x4 v0 = acc[ai][bj][m][0], v1 = acc[ai][bj][m][1]; u32x4 w;
                        w.x = cvt_pk_bf16(fast_sigmoid(v0[0]), fast_sigmoid(v0[1])); w.y = cvt_pk_bf16(fast_sigmoid(v0[2]), fast_sigmoid(v0[3]));
                        w.z = cvt_pk_bf16(fast_sigmoid(v1[0]), fast_sigmoid(v1[1])); w.w = cvt_pk_bf16(fast_sigmoid(v1[2]), fast_sigmoid(v1[3]));
                        *(u32x4*)(rowp + bj * HALF) = w; } }
            return;
        }
        const bool plain = (pn == 3) | (pn == 7) | (pn == 12) | (pn == 13) | (pn >= 14 && pn <= 17);
        if (plain) {
            bf16_t* base; int ld;
            if (pn >= 14) { base = dqkv + (pn >= 16 ? (size_t)MT * 512 : 0) + (pn & 1) * 256 + tc0; ld = 512; } else { base = act + pn * 256 + tc0; ld = LDACT; }
#pragma unroll
            for (int ai = 0; ai < 2; ++ai)
#pragma unroll
                for (int m = 0; m < 4; ++m) { const int row = row0 + ai * HALF + m * 16; bf16_t* rowp = base + (size_t)row * ld; float ss = 0.f;
#pragma unroll
                    for (int bj = 0; bj < 2; ++bj) { const f32x4 v0 = acc[ai][bj][m][0], v1 = acc[ai][bj][m][1]; u32x4 w;
                        ss += (v0[0] * v0[0] + v0[1] * v0[1]) + (v0[2] * v0[2] + v0[3] * v0[3]) + (v1[0] * v1[0] + v1[1] * v1[1]) + (v1[2] * v1[2] + v1[3] * v1[3]);
                        w.x = cvt_pk_bf16(v0[0], v0[1]); w.y = cvt_pk_bf16(v0[2], v0[3]); w.z = cvt_pk_bf16(v1[0], v1[1]); w.w = cvt_pk_bf16(v1[2], v1[3]);
                        *(u32x4*)(rowp + bj * HALF) = w; }
                    if (pn >= 14) { ss += __shfl_xor(ss, 16); ss += __shfl_xor(ss, 32); if (fq == 0) ssq[(size_t)row * 16 + (pn - 14) * 4 + wc] = ss; } }
            return;
        }
        const bool r128 = pn < 8, rms = pn < 3, lat = u.pm < 32;
        float gn[2][4];
        if (rms) { const float* gq = qkn + (pn == 2 ? 128 : 0);
#pragma unroll
            for (int n = 0; n < 2; ++n)
#pragma unroll
                for (int j = 0; j < 4; ++j) gn[n][j] = gq[L128(tc0 + 4 * n + j)];
#pragma unroll
            for (int ai = 0; ai < 2; ++ai)
#pragma unroll
                for (int m = 0; m < 4; ++m)
#pragma unroll
                    for (int bj = 0; bj < 2; ++bj) { const f32x4 v0 = acc[ai][bj][m][0], v1 = acc[ai][bj][m][1];
                        float ss = (v0[0] * v0[0] + v0[1] * v0[1]) + (v0[2] * v0[2] + v0[3] * v0[3]) + (v1[0] * v1[0] + v1[1] * v1[1]) + (v1[2] * v1[2] + v1[3] * v1[3]);
                        ss += __shfl_xor(ss, 16); ss += __shfl_xor(ss, 32);
                        if (fq == 0) xch[((ai * HALF + wr * 64 + m * 16 + fr) * 2 + bj) * 4 + wc] = ss; }
            asm volatile("s_waitcnt lgkmcnt(0)" ::: "memory"); __builtin_amdgcn_s_barrier(); asm volatile("" ::: "memory");
        }
        const int i0 = r128 ? (wc * 16 + 4 * fq) : ((wc & 1) * 16 + 4 * fq);
#pragma unroll
        for (int ai = 0; ai < 2; ++ai)
#pragma unroll
            for (int m = 0; m < 4; ++m) { const int row = row0 + ai * HALF + m * 16, t = row & (SEQ - 1);
                f32x4 cs0 = (f32x4){1.f, 0.f, 1.f, 0.f}, cs1 = cs0;
                if (lat) { const f32x4* tp = r128 ? (t128 + ((size_t)t * 64 + i0) / 2) : (t64 + ((size_t)t * 32 + i0) / 2); cs0 = tp[0]; cs1 = tp[1]; }
#pragma unroll
                for (int bj = 0; bj < 2; ++bj) { f32x4 v0 = acc[ai][bj][m][0], v1 = acc[ai][bj][m][1];
                    if (rms) { const f32x4 p = *(const LAS f32x4*)(xch + ((ai * HALF + wr * 64 + m * 16 + fr) * 2 + bj) * 4);
                        const float rs = __builtin_amdgcn_rsqf(((p[0] + p[1]) + (p[2] + p[3])) * (1.0f / 128.0f) + NORM_EPS);
                        v0[0] *= rs * gn[0][0]; v0[1] *= rs * gn[0][1]; v0[2] *= rs * gn[0][2]; v0[3] *= rs * gn[0][3];
                        v1[0] *= rs * gn[1][0]; v1[1] *= rs * gn[1][1]; v1[2] *= rs * gn[1][2]; v1[3] *= rs * gn[1][3]; }
                    const float a0 = v0[0] * cs0[0] - v0[1] * cs0[1], b0 = v0[1] * cs0[0] + v0[0] * cs0[1];
                    const float a1 = v0[2] * cs0[2] - v0[3] * cs0[3], b1 = v0[3] * cs0[2] + v0[2] * cs0[3];
                    const float a2 = v1[0] * cs1[0] - v1[1] * cs1[1], b2 = v1[1] * cs1[0] + v1[0] * cs1[1];
                    const float a3 = v1[2] * cs1[2] - v1[3] * cs1[3], b3 = v1[3] * cs1[2] + v1[2] * cs1[3];
                    u32x4 w; w.x = cvt_pk_bf16(a0, b0); w.y = cvt_pk_bf16(a1, b1); w.z = cvt_pk_bf16(a2, b2); w.w = cvt_pk_bf16(a3, b3);
                    bf16_t* dst;
                    if (pn == 18) { const int c = bj * HALF + tc0; dst = act + (size_t)row * LDACT + C_DK + (c >> 6) * 192 + 128 + (c & 63); }
                    else dst = act + (size_t)row * LDACT + pn * 256 + bj * HALF + tc0;
                    *(u32x4*)dst = w; } }
    }
};
struct EpiUp {
    static constexpr bool PERM = true;
    bf16_t* act; const float* ssq; const f32x4* t64;
    __device__ __forceinline__ void operator()(const f32x4 (&acc)[2][2][4][2], const Unit& u, int wr, int wc, int fr, int fq) const {
        const int pn = u.pn, row0 = u.pm * BM + wr * 64 + fr, tc0 = wc * 32 + 8 * fq; const bool lat = u.pm < 32;
        const int i0 = (wc & 1) * 16 + 4 * fq;
#pragma unroll
        for (int ai = 0; ai < 2; ++ai)
#pragma unroll
            for (int m = 0; m < 4; ++m) { const int row = row0 + ai * HALF + m * 16, t = row & (SEQ - 1);
                const f32x4* sp = (const f32x4*)(ssq + (size_t)row * 16 + (pn >= 3 ? 8 : 0)); const f32x4 s0 = sp[0], s1 = sp[1];
                const float rs = __builtin_amdgcn_rsqf((((s0[0] + s0[1]) + (s0[2] + s0[3])) + ((s1[0] + s1[1]) + (s1[2] + s1[3]))) * (1.0f / 512.0f) + NORM_EPS);
                f32x4 cs0 = (f32x4){1.f, 0.f, 1.f, 0.f}, cs1 = cs0;
                if (pn == 2 && lat) { const f32x4* tp = t64 + ((size_t)t * 32 + i0) / 2; cs0 = tp[0]; cs1 = tp[1]; }
#pragma unroll
                for (int bj = 0; bj < 2; ++bj) { f32x4 v0 = acc[ai][bj][m][0] * rs, v1 = acc[ai][bj][m][1] * rs; u32x4 w;
                    if (pn == 2) {
                        const float a0 = v0[0] * cs0[0] - v0[1] * cs0[1], b0 = v0[1] * cs0[0] + v0[0] * cs0[1];
                        const float a1 = v0[2] * cs0[2] - v0[3] * cs0[3], b1 = v0[3] * cs0[2] + v0[2] * cs0[3];
                        const float a2 = v1[0] * cs1[0] - v1[1] * cs1[1], b2 = v1[1] * cs1[0] + v1[0] * cs1[1];
                        const float a3 = v1[2] * cs1[2] - v1[3] * cs1[3], b3 = v1[3] * cs1[2] + v1[2] * cs1[3];
                        w.x = cvt_pk_bf16(a0, b0); w.y = cvt_pk_bf16(a1, b1); w.z = cvt_pk_bf16(a2, b2); w.w = cvt_pk_bf16(a3, b3);
                    } else { w.x = cvt_pk_bf16(v0[0], v0[1]); w.y = cvt_pk_bf16(v0[2], v0[3]); w.z = cvt_pk_bf16(v1[0], v1[1]); w.w = cvt_pk_bf16(v1[2], v1[3]); }
                    const int c = bj * HALF + tc0; int col;
                    if (pn < 2) col = C_DQ + (pn * 2 + bj) * 192 + tc0;
                    else if (pn == 2) col = C_DQ + (c >> 6) * 192 + 128 + (c & 63);
                    else if (pn < 5) col = C_DK + ((pn - 3) * 2 + bj) * 192 + tc0;
                    else col = C_DV + (pn - 5) * 256 + c;
                    *(u32x4*)(act + (size_t)row * LDACT + col) = w; } }
    }
};
struct EpiMerge {
    static constexpr bool PERM = true;
    bf16_t* gates;
    __device__ __forceinline__ void operator()(const f32x4 (&acc)[2][2][4][2], const Unit& u, int wr, int wc, int fr, int fq) const {
        const int row0 = u.pm * BM + wr * 64 + fr, tc0 = wc * 32 + 8 * fq;
#pragma unroll
        for (int ai = 0; ai < 2; ++ai)
#pragma unroll
            for (int m = 0; m < 4; ++m) { bf16_t* rowp = gates + (size_t)(row0 + ai * HALF + m * 16) * 8192 + u.pn * 256 + tc0;
                u32x4 gv[2];
#pragma unroll
                for (int bj = 0; bj < 2; ++bj) gv[bj] = *(const u32x4*)(rowp + bj * HALF);
#pragma unroll
                for (int bj = 0; bj < 2; ++bj) { const f32x4 v0 = acc[ai][bj][m][0], v1 = acc[ai][bj][m][1]; const u32x4 g = gv[bj]; u32x4 w;
                    w.x = cvt_pk_bf16(v0[0] * bf_lo(g.x), v0[1] * bf_hi(g.x)); w.y = cvt_pk_bf16(v0[2] * bf_lo(g.y), v0[3] * bf_hi(g.y));
                    w.z = cvt_pk_bf16(v1[0] * bf_lo(g.z), v1[1] * bf_hi(g.z)); w.w = cvt_pk_bf16(v1[2] * bf_lo(g.w), v1[3] * bf_hi(g.w));
                    *(u32x4*)(rowp + bj * HALF) = w; } }
    }
};
struct EpiRes {
    static constexpr bool PERM = false;
    const float* x; float* pre; const float* gvec; float* part;
    __device__ __forceinline__ void operator()(const f32x4 (&acc)[2][2][4][2], const Unit& u, int wr, int wc, int fr, int fq) const {
        const int row0 = u.pm * BM + wr * 64 + fr, col0 = u.pn * BM + wc * 32 + 4 * fq;
        const float* gp = gvec + (size_t)(u.pm < 32 ? (u.pm >> 3) : 4) * (6 * DM) + col0;
        const float al = (u.ks > 0) ? 0.0f : ALPHA;
        float* dst = (u.ks >= 0) ? part + ((size_t)u.ks * MC - ML) * DM : pre;
        f32x4 gv[2][2];
#pragma unroll
        for (int bj = 0; bj < 2; ++bj)
#pragma unroll
            for (int n = 0; n < 2; ++n) gv[bj][n] = *(const f32x4*)(gp + bj * HALF + n * 16);
#pragma unroll
        for (int ai = 0; ai < 2; ++ai)
#pragma unroll
            for (int m = 0; m < 4; ++m) { const size_t off = (size_t)(row0 + ai * HALF + m * 16) * DM + col0;
#pragma unroll
                for (int bj = 0; bj < 2; ++bj)
#pragma unroll
                    for (int n = 0; n < 2; ++n) { const f32x4 xv = *(const f32x4*)(x + off + bj * HALF + n * 16);
                        *(f32x4*)(dst + off + bj * HALF + n * 16) = xv * al + gv[bj][n] * acc[ai][bj][m][n]; }
                asm volatile("" ::: "memory"); }
    }
};
struct EpiSwi {
    static constexpr bool PERM = true;
    bf16_t* fh;
    __device__ __forceinline__ void operator()(const f32x4 (&acc)[2][2][4][2], const Unit& u, int wr, int wc, int fr, int fq) const {
        const int row0 = u.pm * BM + wr * 64 + fr, col0 = u.pn * 128 + wc * 32 + 8 * fq;
#pragma unroll
        for (int ai = 0; ai < 2; ++ai)
#pragma unroll
            for (int m = 0; m < 4; ++m) { const f32x4 g0 = acc[ai][0][m][0], g1 = acc[ai][0][m][1], u0 = acc[ai][1][m][0], u1 = acc[ai][1][m][1]; u32x4 w;
                w.x = cvt_pk_bf16(g0[0] * fast_sigmoid(g0[0]) * u0[0], g0[1] * fast_sigmoid(g0[1]) * u0[1]);
                w.y = cvt_pk_bf16(g0[2] * fast_sigmoid(g0[2]) * u0[2], g0[3] * fast_sigmoid(g0[3]) * u0[3]);
                w.z = cvt_pk_bf16(g1[0] * fast_sigmoid(g1[0]) * u1[0], g1[1] * fast_sigmoid(g1[1]) * u1[1]);
                w.w = cvt_pk_bf16(g1[2] * fast_sigmoid(g1[2]) * u1[2], g1[3] * fast_sigmoid(g1[3]) * u1[3]);
                *(u32x4*)(fh + (size_t)(row0 + ai * HALF + m * 16) * FF + col0) = w; }
    }
};
}

namespace att {
constexpr int NW = 8, QBLK = 32, KVBLK = 64;
constexpr int SHM_V = KVBLK * 128 * 2;
#define SBAR() __builtin_amdgcn_sched_barrier(0)
__device__ __forceinline__ int crow(int r, int hi) { return (r & 3) + 8 * (r >> 2) + 4 * hi; }
__device__ __forceinline__ int v_st(int k, int c) { const int kk = (k & ~0xC) | ((k & 4) << 1) | ((k & 8) >> 1); return ((kk >> 3) * 4 + (c >> 5)) * 512 + ((kk & 7) * 32 + (c & 31)) * 2; }
__device__ __forceinline__ int v_rd_base(int lane) { return ((lane & 3) << 3) | (((lane >> 2) & 3) << 6) | (((lane >> 4) & 1) << 5) | (((lane >> 5) & 1) << 8); }
constexpr int v_rd_off(int d0, int ks, int half) { return d0 * 512 + ks * 4096 + half * 2048; }
template <int OFF> __device__ __forceinline__ s16x4 tr_read(int vb) { s16x4 r; asm volatile("ds_read_b64_tr_b16 %0, %1 offset:%2" : "=&v"(r) : "v"(vb), "i"(OFF) : "memory"); return r; }
template <int D0> __device__ __forceinline__ void pv_one(f32x16& od, int vb, bf16x8 pa0, bf16x8 pa1, bf16x8 pa2, bf16x8 pa3) {
    const s16x4 l0 = tr_read<v_rd_off(D0, 0, 0)>(vb), h0 = tr_read<v_rd_off(D0, 0, 1)>(vb), l1 = tr_read<v_rd_off(D0, 1, 0)>(vb), h1 = tr_read<v_rd_off(D0, 1, 1)>(vb);
    const s16x4 l2 = tr_read<v_rd_off(D0, 2, 0)>(vb), h2 = tr_read<v_rd_off(D0, 2, 1)>(vb), l3 = tr_read<v_rd_off(D0, 3, 0)>(vb), h3 = tr_read<v_rd_off(D0, 3, 1)>(vb);
    asm volatile("s_waitcnt lgkmcnt(0)" ::: "memory"); SBAR();
#define PK(L, H) (bf16x8){L[0], L[1], L[2], L[3], H[0], H[1], H[2], H[3]}
    od = __builtin_amdgcn_mfma_f32_32x32x16_bf16(pa0, PK(l0, h0), od, 0, 0, 0);
    od = __builtin_amdgcn_mfma_f32_32x32x16_bf16(pa1, PK(l1, h1), od, 0, 0, 0);
    od = __builtin_amdgcn_mfma_f32_32x32x16_bf16(pa2, PK(l2, h2), od, 0, 0, 0);
    od = __builtin_amdgcn_mfma_f32_32x32x16_bf16(pa3, PK(l3, h3), od, 0, 0, 0);
#undef PK
}
__device__ __forceinline__ void pv_d0(f32x16* o, int vb, bf16x8 pa0, bf16x8 pa1, bf16x8 pa2, bf16x8 pa3) {
    pv_one<0>(o[0], vb, pa0, pa1, pa2, pa3); pv_one<1>(o[1], vb, pa0, pa1, pa2, pa3); pv_one<2>(o[2], vb, pa0, pa1, pa2, pa3); pv_one<3>(o[3], vb, pa0, pa1, pa2, pa3);
}
template <bool BAND>
__device__ __forceinline__ void partialSM(f32x16& p0, f32x16& p1, float& m_reg, float& mn, float& alpha, const float C, const float thr, bool domask, int dk, int hi) {
    if (BAND) { if (domask) {
#pragma unroll
        for (int r = 0; r < 16; ++r) { const int kk = dk + crow(r, hi); if ((unsigned)(kk + 128) > 256u) p0[r] = -1e30f; if ((unsigned)(kk + 160) > 256u) p1[r] = -1e30f; } } }
    float pmax = p0[0];
#pragma unroll
    for (int r = 1; r < 16; ++r) pmax = fmaxf(pmax, p0[r]);
#pragma unroll
    for (int r = 0; r < 16; ++r) pmax = fmaxf(pmax, p1[r]);
    { auto rr = __builtin_amdgcn_permlane32_swap(__float_as_uint(pmax), __float_as_uint(pmax), false, false); pmax = fmaxf(__uint_as_float(rr[0]), __uint_as_float(rr[1])); }
    if (__builtin_expect(__all(pmax - m_reg <= thr), 1)) { mn = m_reg; alpha = 1.f; }
    else { mn = fmaxf(m_reg, pmax); alpha = __builtin_amdgcn_exp2f((m_reg - mn) * C); m_reg = mn; }
    const float mnC = -mn * C;
#pragma unroll
    for (int r = 0; r < 16; ++r) p0[r] = fmaf(p0[r], C, mnC);
#pragma unroll
    for (int r = 0; r < 16; ++r) p1[r] = fmaf(p1[r], C, mnC);
#pragma unroll
    for (int r = 0; r < 16; ++r) p0[r] = __builtin_amdgcn_exp2f(p0[r]);
}
__device__ __forceinline__ void finishSM(f32x16& p0, f32x16& p1, float alpha, float& l_reg, bf16x8& pa0, bf16x8& pa1, bf16x8& pa2, bf16x8& pa3) {
#pragma unroll
    for (int r = 0; r < 16; ++r) p1[r] = __builtin_amdgcn_exp2f(p1[r]);
    float ps = 0;
#pragma unroll
    for (int r = 0; r < 16; ++r) ps += p0[r];
#pragma unroll
    for (int r = 0; r < 16; ++r) ps += p1[r];
    { auto rr = __builtin_amdgcn_permlane32_swap(__float_as_uint(ps), __float_as_uint(ps), false, false); ps = __uint_as_float(rr[0]) + __uint_as_float(rr[1]); }
    l_reg = l_reg * alpha + ps;
#define PK4(P, BASE, OUT) do { unsigned a0 = cvt_pk_bf16(P[BASE + 0], P[BASE + 1]), a1 = cvt_pk_bf16(P[BASE + 2], P[BASE + 3]);   \
    unsigned b0 = cvt_pk_bf16(P[BASE + 4], P[BASE + 5]), b1 = cvt_pk_bf16(P[BASE + 6], P[BASE + 7]);                              \
    auto r0 = __builtin_amdgcn_permlane32_swap(a0, b0, false, false); auto r1 = __builtin_amdgcn_permlane32_swap(a1, b1, false, false); \
    u32x4 w = {r0[0], r1[0], r0[1], r1[1]}; OUT = *reinterpret_cast<bf16x8*>(&w); } while (0)
    PK4(p0, 0, pa0); PK4(p0, 8, pa1); PK4(p1, 0, pa2); PK4(p1, 8, pa3);
#undef PK4
}
#define KSWZP(row, colB, PITCH) ((row) * (PITCH) + ((colB) ^ (((row) & 7) << 4)))
template <int DQK>
__device__ __forceinline__ void qkt(f32x16& p0, f32x16& p1, const char* Ks, const bf16x8* qr, int r32, int hi) {
    p0 = f32x16{}; p1 = f32x16{};
#pragma unroll
    for (int d0 = 0; d0 < DQK / 16; ++d0) { const int cb = (d0 * 16 + hi * 8) * 2;
        const bf16x8 b0 = *reinterpret_cast<const bf16x8*>(Ks + KSWZP(r32, cb, DQK * 2));
        const bf16x8 b1 = *reinterpret_cast<const bf16x8*>(Ks + KSWZP(32 + r32, cb, DQK * 2));
        p0 = __builtin_amdgcn_mfma_f32_32x32x16_bf16(b0, qr[d0], p0, 0, 0, 0);
        p1 = __builtin_amdgcn_mfma_f32_32x32x16_bf16(b1, qr[d0], p1, 0, 0, 0); }
}
struct UnitArgs {
    const bf16_t* Qb; int ldq;
    const bf16_t* Kb; int ldk;
    const bf16_t* Vb; int ldv;
    int crow0, lrow0, ntc, nt;
    int dpos;
    float sink;
    bf16_t* out; int ldo;
    float* scr;
    float lam, omli; const float* gsub;
    int epi;
};
template <int DQK, bool BAND, bool SINK, int EPI>
__device__ __forceinline__ void attn_unit(const UnitArgs& a, char* lds) {
    constexpr int SDEPTH = (DQK == 192) ? 1 : 2;
    constexpr int NKC = DQK / 64, CH = DQK / 8, SHM_K = KVBLK * DQK * 2;
    constexpr float SCALE = (DQK == 64) ? 0.125f : (DQK == 128 ? 0.088388347648318440f : 0.072168783648703220f);
    constexpr float C = SCALE * 1.4426950408889634f, THRS = 8.0f / SCALE;
    int tid_ = threadIdx.x; asm volatile("" : "+v"(tid_));
    const int tid = tid_, wid = tid >> 6, lane = tid & 63, r32 = lane & 31, hi = lane >> 5;
    char* V_lds = lds; char* K_lds = lds + 2 * SHM_V;
    float* wsf = (float*)(lds + 2 * SHM_V + 2 * SHM_K) + wid * 64; float* li_l = wsf; float* al_l = wsf + 32;
    float m_reg = -1e30f, l_reg = 0; f32x16 o[4] = {}; bf16x8 qr[DQK / 16];
    const bf16_t* Qw = a.Qb + (long)(wid * QBLK + r32) * a.ldq + hi * 8;
#pragma unroll
    for (int d0 = 0; d0 < DQK / 16; ++d0) qr[d0] = *reinterpret_cast<const bf16x8*>(Qw + d0 * 16);
    const int sr = tid >> 4, sc = (tid & 15) * 8, vst0 = v_st(sr, sc), vst1 = v_st(32 + sr, sc);
#define KCOORD(q_, KR, KC) int t__ = tid; if constexpr (NKC == 3) asm volatile("" : "+v"(t__)); const int qq__ = t__ + 512 * (q_); const int KR = qq__ / CH, KC = (qq__ % CH) * 8;
    const int vb0 = (int)(uintptr_t)V_lds + v_rd_base(lane);
    struct { bf16x8 vs0, vs1, ks[NKC]; } sr_[SDEPTH];
    const int dk0 = a.dpos - wid * QBLK - r32;
#define TROW(j) (((j) < a.ntc) ? (a.crow0 + KVBLK * (j)) : (a.lrow0 + KVBLK * ((j) - a.ntc)))
#define SLOAD(i, j) do { const int R0_ = TROW(j); sr_[i].vs0 = *reinterpret_cast<const bf16x8*>(a.Vb + (long)(R0_ + sr) * a.ldv + sc); sr_[i].vs1 = *reinterpret_cast<const bf16x8*>(a.Vb + (long)(R0_ + 32 + sr) * a.ldv + sc); \
    _Pragma("unroll") for (int q_ = 0; q_ < NKC; ++q_) { KCOORD(q_, kr_, kc_) sr_[i].ks[q_] = *reinterpret_cast<const bf16x8*>(a.Kb + (long)(R0_ + kr_) * a.ldk + kc_); } } while (0)
#define SWRITE(b, i) do { *(bf16x8*)(V_lds + (b) * SHM_V + vst0) = sr_[i].vs0; *(bf16x8*)(V_lds + (b) * SHM_V + vst1) = sr_[i].vs1; \
    _Pragma("unroll") for (int q_ = 0; q_ < NKC; ++q_) { KCOORD(q_, kr_, kc_) *(bf16x8*)(K_lds + (b) * SHM_K + KSWZP(kr_, kc_ * 2, DQK * 2)) = sr_[i].ks[q_]; } } while (0)
#define SWAIT() do { if constexpr (SDEPTH == 2) { if constexpr (NKC == 1) asm volatile("s_waitcnt vmcnt(3)" ::: "memory"); else asm volatile("s_waitcnt vmcnt(4)" ::: "memory"); } else asm volatile("s_waitcnt vmcnt(0)" ::: "memory"); } while (0)
#define RESC(al) do { if (__any((al) < 1.f)) { if (hi == 0) al_l[r32] = (al); asm volatile("s_waitcnt lgkmcnt(0)" ::: "memory"); \
    _Pragma("unroll") for (int d = 0; d < 4; ++d) _Pragma("unroll") for (int r = 0; r < 16; ++r) o[d][r] *= al_l[crow(r, hi)]; } } while (0)
#define PSM(P0, P1, MN, AL, j) partialSM<BAND>(P0, P1, m_reg, MN, AL, C, THRS, (j) >= a.ntc, dk0 + KVBLK * ((j) - a.ntc), hi)
    f32x16 pA0, pA1, pB0, pB1; float mnA, mnB, alA, alB; bf16x8 pa0, pa1, pa2, pa3; const int NT = a.nt;
    constexpr int SE = 0, SO = SDEPTH - 1;
    SLOAD(SE, 0); asm volatile("s_waitcnt vmcnt(0)" ::: "memory"); SWRITE(0, SE); __syncthreads();
    qkt<DQK>(pA0, pA1, K_lds, qr, r32, hi); PSM(pA0, pA1, mnA, alA, 0);
    SLOAD(SO, 1); if constexpr (SDEPTH == 2) { if (2 < NT) SLOAD(SE, 2); }
    SWAIT(); SWRITE(1, SO); __syncthreads();
    for (int j = 1; j + 1 < NT; j += 2) {
        SBAR(); qkt<DQK>(pB0, pB1, K_lds + SHM_K, qr, r32, hi);
        finishSM(pA0, pA1, alA, l_reg, pa0, pa1, pa2, pa3); SBAR();
        SLOAD(SO, j + SDEPTH); SBAR();
        pv_d0(o, vb0, pa0, pa1, pa2, pa3); PSM(pB0, pB1, mnB, alB, j);
        __syncthreads(); SWAIT(); SWRITE(0, SE);
        RESC(alB); __syncthreads();
        SBAR(); qkt<DQK>(pA0, pA1, K_lds, qr, r32, hi);
        finishSM(pB0, pB1, alB, l_reg, pa0, pa1, pa2, pa3); SBAR();
        if (SDEPTH == 1 || j + 3 < NT) SLOAD(SE, j + 1 + SDEPTH); SBAR();
        pv_d0(o, vb0 + SHM_V, pa0, pa1, pa2, pa3); PSM(pA0, pA1, mnA, alA, j + 1);
        __syncthreads(); SWAIT(); SWRITE(1, SO);
        RESC(alA); __syncthreads();
    }
    SBAR(); qkt<DQK>(pB0, pB1, K_lds + SHM_K, qr, r32, hi);
    finishSM(pA0, pA1, alA, l_reg, pa0, pa1, pa2, pa3); SBAR();
    pv_d0(o, vb0, pa0, pa1, pa2, pa3); PSM(pB0, pB1, mnB, alB, NT - 1);
    __syncthreads(); RESC(alB);
    finishSM(pB0, pB1, alB, l_reg, pa0, pa1, pa2, pa3); SBAR();
    pv_d0(o, vb0 + SHM_V, pa0, pa1, pa2, pa3);
    if (SINK) l_reg += __builtin_amdgcn_exp2f(a.sink * 1.4426950408889634f - m_reg * C);
    if (hi == 0) li_l[r32] = l_reg; asm volatile("s_waitcnt lgkmcnt(0)" ::: "memory");
    float rli[16];
#pragma unroll
    for (int r = 0; r < 16; ++r) rli[r] = __builtin_amdgcn_rcpf(li_l[crow(r, hi)]);
#define OROW(r) int orow = crow(r, hi); asm volatile("" : "+v"(orow));
    if (EPI == 0) {
        bf16_t* Ow = a.out + (long)(wid * QBLK) * a.ldo + r32;
#pragma unroll
        for (int r = 0; r < 16; ++r) { OROW(r) bf16_t* op = Ow + (long)orow * a.ldo;
#pragma unroll
            for (int d0 = 0; d0 < 4; ++d0) op[d0 * 32] = (bf16_t)(cvt_pk_bf16(o[d0][r] * rli[r], 0.f) & 0xffffu); }
    } else if (EPI == 1) {
        float* Sw = a.scr + (long)(wid * QBLK) * 512 + r32;
#pragma unroll
        for (int r = 0; r < 16; ++r) { OROW(r) float* sp = Sw + (long)orow * 512;
#pragma unroll
            for (int d0 = 0; d0 < 4; ++d0) sp[d0 * 32] = o[d0][r] * rli[r]; }
        asm volatile("s_waitcnt vmcnt(0)" ::: "memory");
    } else {
        const float* Sw = a.scr + (long)(wid * QBLK) * 512 + r32; bf16_t* Ow = a.out + (long)(wid * QBLK) * a.ldo + r32;
#pragma unroll
        for (int r = 0; r < 16; ++r) { OROW(r) const float* sp = Sw + (long)orow * 512; bf16_t* op = Ow + (long)orow * a.ldo; float d[4]; float ss = 0.f;
#pragma unroll
            for (int d0 = 0; d0 < 4; ++d0) { d[d0] = sp[d0 * 32] - a.lam * (o[d0][r] * rli[r]); ss += d[d0] * d[d0]; }
            ss += __shfl_xor(ss, 1); ss += __shfl_xor(ss, 2); ss += __shfl_xor(ss, 4); ss += __shfl_xor(ss, 8); ss += __shfl_xor(ss, 16);
            const float rs = __builtin_amdgcn_rsqf(ss * (1.0f / 128.0f) + NORM_EPS) * a.omli;
#pragma unroll
            for (int d0 = 0; d0 < 4; ++d0) op[d0 * 32] = (bf16_t)(cvt_pk_bf16(d[d0] * rs * a.gsub[d0 * 32 + r32], 0.f) & 0xffffu);
            if ((r & 3) == 3) asm volatile("" ::: "memory"); }
    }
#undef OROW
    __syncthreads();
#undef TROW
#undef KCOORD
#undef SLOAD
#undef SWRITE
#undef SWAIT
#undef RESC
#undef PSM
}
}

#define XB_TMO      128
#define XB_XCNT(j)  (256  + 64 * (j))
#define XB_XSUB(j)  (1280 + 64 * (j))
#define XB_XGEN(j)  (2304 + 64 * (j))
#define XB_TOP      3328
#define XB_TOPGEN   3392
#define XCD_BAR_WORDS 3456
#define XB_SPIN_CAP (1u << 18)
__device__ __forceinline__ unsigned xb_ld(unsigned* p)              { return __hip_atomic_load(p, __ATOMIC_RELAXED, __HIP_MEMORY_SCOPE_AGENT); }
__device__ __forceinline__ unsigned xb_add(unsigned* p, unsigned v) { return __hip_atomic_fetch_add(p, v, __ATOMIC_RELAXED, __HIP_MEMORY_SCOPE_AGENT); }
__device__ __forceinline__ unsigned xb_xcc_id() { return (unsigned)__builtin_amdgcn_s_getreg((3 << 11) | 20) & 0xFu; }
#define XB_SPIN(cond, bar) do { unsigned _sp = 0; while (cond) { __builtin_amdgcn_s_sleep(1); \
    if ((++_sp & 255u) == 0u) { if (xb_ld(&(bar)[XB_TMO])) break; if (_sp > XB_SPIN_CAP) { atomicAdd(&(bar)[XB_TMO], 1u); break; } } } } while (0)
struct XcdBarrier { unsigned* bar; unsigned x; volatile LAS unsigned* st; };
__device__ __forceinline__ XcdBarrier xcd_barrier_post(unsigned* bar, volatile LAS unsigned* st) {
    XcdBarrier b; b.bar = bar; b.x = xb_xcc_id(); b.st = st;
    if (threadIdx.x == 0) (void)xb_add(&bar[XB_XCNT(b.x)], 1u);
    return b;
}
__device__ __forceinline__ void xcd_barrier_complete(unsigned* bar, unsigned x, unsigned& nloc, unsigned& nx) {
    const unsigned G = gridDim.x * gridDim.y * gridDim.z;
    unsigned sum, cnt, mine, sp = 0u;
    for (;;) {
        sum = 0u; cnt = 0u; mine = 0u;
#pragma unroll
        for (unsigned j = 0; j < 16; ++j) { const unsigned c = xb_ld(&bar[XB_XCNT(j)]); sum += c; cnt += (c > 0u) ? 1u : 0u; mine = (j == x) ? c : mine; }
        if (sum == G) break;
        __builtin_amdgcn_s_sleep(1);
        if ((++sp & 255u) == 0u) { if (xb_ld(&bar[XB_TMO])) break; if (sp > XB_SPIN_CAP) { atomicAdd(&bar[XB_TMO], 1u); break; } }
    }
    nloc = mine > 0u ? mine : 1u; nx = cnt > 0u ? cnt : 1u;
}
__device__ __forceinline__ void xcd_barrier(const XcdBarrier& b) {
    asm volatile("s_waitcnt vmcnt(0)" ::: "memory");
    __syncthreads();
    if (threadIdx.x == 0) {
        unsigned* bar = b.bar;
        __builtin_amdgcn_s_waitcnt(0);
        unsigned nloc = b.st[0], nx = b.st[1];
        if (nloc == 0u) { xcd_barrier_complete(bar, b.x, nloc, nx); b.st[0] = nloc; b.st[1] = nx; }
        const unsigned old = xb_add(&bar[XB_XSUB(b.x)], 1u);
        const unsigned gen = old / nloc;
        if (old + 1u == (gen + 1u) * nloc) {
            __builtin_amdgcn_fence(__ATOMIC_RELEASE, "agent");
            asm volatile("s_waitcnt vmcnt(0)" ::: "memory");
            const unsigned og = xb_add(&bar[XB_TOP], 1u);
            const unsigned tg = og / nx;
            if (og + 1u == (tg + 1u) * nx) xb_add(&bar[XB_TOPGEN], 1u);
            else XB_SPIN(xb_ld(&bar[XB_TOPGEN]) == tg, bar);
            __builtin_amdgcn_fence(__ATOMIC_ACQUIRE, "agent");
            xb_add(&bar[XB_XGEN(b.x)], 1u);
            asm volatile("s_waitcnt vmcnt(0)" ::: "memory");
        } else {
            XB_SPIN(xb_ld(&bar[XB_XGEN(b.x)]) == gen, bar);
            __builtin_amdgcn_fence(__ATOMIC_ACQUIRE, "agent");
            asm volatile("s_waitcnt vmcnt(0)" ::: "memory");
        }
    }
    __syncthreads();
}

struct Args {
    const float* in[23];
    float* out; unsigned char* ws;
    int ph_lo, ph_hi;
};
typedef const __attribute__((address_space(4))) Args* ArgsP;
enum { I_X = 0, I_C, I_CTX, I_CCTX, I_WADA, I_BADA, I_WIN, I_AQKN, I_BSINK, I_CLAM, I_CSUBLN, I_MQN, I_MWQ, I_MKVN, I_MWKV, I_WBR, I_WOUT, I_LMG, I_LMB, I_WFI, I_WFO, I_LFG, I_LFB };
constexpr int NPH_LAYER = 10, NPH_PRO = 2, NPH_TOTAL = NPH_PRO + DEPTH * NPH_LAYER;

template <class SrcFn>
__device__ __forceinline__ void cvt_item(const float* W, int K, int Nsrc, bf16_t* WT, const float* kscale, LAS float* scr, int kb, int nb, int lane, SrcFn srcf) {
    const int k0 = 64 * kb, n0 = 32 * nb; const int sc = srcf(n0 + (lane & 31));
    float v[32];
    const float* wp = W + (size_t)(k0 + (lane >> 5)) * Nsrc + sc;
#pragma unroll
    for (int i = 0; i < 32; ++i) v[i] = wp[(size_t)(2 * i) * Nsrc];
    if (kscale) {
#pragma unroll
        for (int i = 0; i < 32; ++i) v[i] *= kscale[k0 + 2 * i + (lane >> 5)]; }
#pragma unroll
    for (int i = 0; i < 32; ++i) scr[(2 * i + (lane >> 5)) * 33 + (lane & 31)] = v[i];
    asm volatile("s_waitcnt lgkmcnt(0)" ::: "memory");
    const int c = lane & 7;
#pragma unroll
    for (int j = 0; j < 4; ++j) { const int n = (lane >> 3) + 8 * j; const LAS float* s = scr + (8 * c) * 33 + n;
        u32x4 o; o.x = cvt_pk_bf16(s[0 * 33], s[1 * 33]); o.y = cvt_pk_bf16(s[2 * 33], s[3 * 33]); o.z = cvt_pk_bf16(s[4 * 33], s[5 * 33]); o.w = cvt_pk_bf16(s[6 * 33], s[7 * 33]);
        *(u32x4*)(WT + (size_t)(n0 + n) * K + k0 + 8 * c) = o; }
    asm volatile("s_waitcnt lgkmcnt(0)" ::: "memory");
}
constexpr int IT_IN = (DM / 64) * (NIN / 32), IT_QUP = (512 / 64) * (768 / 32), IT_KVUP = (512 / 64) * (1024 / 32), IT_BR = 4 * (512 / 64) * (DM / 32), IT_OUT = (DM / 64) * (DM / 32),
              IT_FI = (DM / 64) * (2 * FF / 32), IT_FO = (FF / 64) * (DM / 32), IT_LAYER = IT_IN + IT_QUP + IT_KVUP + IT_BR + IT_OUT + IT_FI + IT_FO;
__device__ __forceinline__ void convert_weights_item(ArgsP Ap, int it, LAS float* scr, int lane) {
    const auto& A = *Ap;
    const int l = it / IT_LAYER; int r = it % IT_LAYER;
    unsigned char* wl = A.ws + WS_W + (size_t)l * WL_SIZE;
    if (r < IT_IN) { const int nblk = NIN / 32; cvt_item(A.in[I_WIN] + (size_t)l * DM * NIN_SRC, DM, NIN_SRC, (bf16_t*)(wl + WL_IN), nullptr, scr, r / nblk, r % nblk, lane, [](int n) { return win_src(n); }); return; } r -= IT_IN;
    if (r < IT_QUP) { const int nblk = 768 / 32; cvt_item(A.in[I_MWQ] + (size_t)l * 512 * 768, 512, 768, (bf16_t*)(wl + WL_UP), A.in[I_MQN] + l * 512, scr, r / nblk, r % nblk, lane,
        [](int n) { return n < 512 ? (n >> 7) * 192 + (n & 127) : ((n - 512) >> 6) * 192 + 128 + L64((n - 512) & 63); }); return; } r -= IT_QUP;
    if (r < IT_KVUP) { const int nblk = 1024 / 32; cvt_item(A.in[I_MWKV] + (size_t)l * 512 * 1024, 512, 1024, (bf16_t*)(wl + WL_UP) + (size_t)768 * 512, A.in[I_MKVN] + l * 512, scr, r / nblk, r % nblk, lane,
        [](int n) { return n < 512 ? (n >> 7) * 256 + (n & 127) : ((n - 512) >> 7) * 256 + 128 + ((n - 512) & 127); }); return; } r -= IT_KVUP;
    if (r < IT_BR) { const int per = IT_BR / 4, m = r / per, rr = r % per, nblk = DM / 32;
        cvt_item(A.in[I_WBR] + ((size_t)l * 4 + m) * 512 * DM, 512, DM, (bf16_t*)(wl + WL_BR) + (size_t)m * DM * 512, nullptr, scr, rr / nblk, rr % nblk, lane, [](int n) { return n; }); return; } r -= IT_BR;
    if (r < IT_OUT) { const int nblk = DM / 32; cvt_item(A.in[I_WOUT] + (size_t)l * DM * DM, DM, DM, (bf16_t*)(wl + WL_OUT), nullptr, scr, r / nblk, r % nblk, lane, [](int n) { return n; }); return; } r -= IT_OUT;
    if (r < IT_FI) { const int nblk = 2 * FF / 32; cvt_item(A.in[I_WFI] + (size_t)l * DM * 2 * FF, DM, 2 * FF, (bf16_t*)(wl + WL_FI), nullptr, scr, r / nblk, r % nblk, lane,
        [](int n) { const int t = n >> 8, w = n & 255; return w < 128 ? t * 128 + w : FF + t * 128 + (w - 128); }); return; } r -= IT_FI;
    { const int nblk = DM / 32; cvt_item(A.in[I_WFO] + (size_t)l * FF * DM, FF, DM, (bf16_t*)(wl + WL_FO), nullptr, scr, r / nblk, r % nblk, lane, [](int n) { return n; }); }
}
__device__ __forceinline__ void ada_unit(ArgsP Ap, int unit, LAS unsigned char* lds, int tid) {
    const auto& A = *Ap;
    LAS float* sl = (LAS float*)lds;
    LAS float* red = (LAS float*)(lds + 40960);
    const int l = unit / 48, cb = unit % 48, wid = tid >> 6, lane = tid & 63;
    for (int i = tid; i < 5 * DM; i += 512) { const int r = i / DM, k = i % DM; const float v = r < 4 ? A.in[I_C][r * DM + k] : A.in[I_CCTX][k]; sl[i] = v / (1.0f + __expf(-v)); }
    __syncthreads();
    const float* W = A.in[I_WADA] + (size_t)l * DM * (6 * DM) + cb * 256 + lane * 4;
    f32x4 acc[5];
#pragma unroll
    for (int r = 0; r < 5; ++r) acc[r] = (f32x4){0.f, 0.f, 0.f, 0.f};
    const int kbeg = wid * 256;
    for (int k = kbeg; k < kbeg + 256; k += 8) {
        f32x4 w[8];
#pragma unroll
        for (int j = 0; j < 8; ++j) w[j] = *(const f32x4*)(W + (size_t)(k + j) * (6 * DM));
#pragma unroll
        for (int j = 0; j < 8; ++j)
#pragma unroll
            for (int r = 0; r < 5; ++r) { const float s = sl[r * DM + k + j]; acc[r] += w[j] * s; }
    }
#pragma unroll
    for (int r = 0; r < 5; ++r) *(LAS f32x4*)(red + (wid * 5 + r) * 256 + lane * 4) = acc[r];
    __syncthreads();
    for (int i = tid; i < 5 * 256; i += 512) { const int r = i / 256, c = i % 256; float s = 0.f;
#pragma unroll
        for (int w = 0; w < 8; ++w) s += red[(w * 5 + r) * 256 + c];
        const int col = cb * 256 + c;
        ((float*)(A.ws + WS_ADA))[((size_t)l * 5 + r) * (6 * DM) + col] = s + A.in[I_BADA][(size_t)l * 6 * DM + col]; }
    __syncthreads();
}
__device__ __forceinline__ void ln_row(const float* src, float* xdst, bf16_t* hdst, const float* gam, const float* bet, const float* sc, const float* sh, int lane_, size_t slab = 0) {
    int lane = lane_; asm volatile("" : "+v"(lane));
    f32x4 v[8]; float s = 0.f;
#pragma unroll
    for (int j = 0; j < 8; ++j) { const float* p = src + 256 * j + 4 * lane; v[j] = *(const f32x4*)p;
        if (slab) v[j] = (v[j] + *(const f32x4*)(p + slab)) + (*(const f32x4*)(p + 2 * slab) + *(const f32x4*)(p + 3 * slab));
        s += (v[j][0] + v[j][1]) + (v[j][2] + v[j][3]); }
    const float mean = wave_sum(s) * (1.0f / DM); float q = 0.f;
#pragma unroll
    for (int j = 0; j < 8; ++j) { v[j] = v[j] - mean; q += (v[j][0] * v[j][0] + v[j][1] * v[j][1]) + (v[j][2] * v[j][2] + v[j][3] * v[j][3]); }
    const float rstd = 1.0f / sqrtf(wave_sum(q) * (1.0f / DM) + NORM_EPS);
#pragma unroll
    for (int j = 0; j < 8; ++j) { const int c = 256 * j + 4 * lane; f32x4 y = v[j] * rstd;
        if (gam) y = y * *(const f32x4*)(gam + c) + *(const f32x4*)(bet + c);
        *(f32x4*)(xdst + c) = y;
        if (hdst) { const f32x4 h = y * (*(const f32x4*)(sc + c) + 1.0f) + *(const f32x4*)(sh + c); u32x2 w; w.x = cvt_pk_bf16(h[0], h[1]); w.y = cvt_pk_bf16(h[2], h[3]); *(u32x2*)(hdst + c) = w; } }
}

__device__ __forceinline__ ArgsP args_ptr() { ArgsP p = (ArgsP)__builtin_amdgcn_kernarg_segment_ptr(); asm volatile("" : "+s"(p)); return p; }
#define WSP(T, off) ((T*)(ws + (off)))
#define PH_ENTER() ArgsP ap = args_ptr(); unsigned char* ws = ap->ws; int Gp = (int)gridDim.x, bxp = (int)blockIdx.x; asm volatile("" : "+s"(Gp), "+s"(bxp)); (void)Gp; (void)bxp


#define TAIL_CONVERT_FROM(first_idle, i0, i1) do { if (l + 1 < DEPTH) { const int rem_ = (first_idle); if (rem_ > 0 && rem_ < Gp && bxp >= rem_) { const int nw_ = (Gp - rem_) * 8, w_ = (bxp - rem_) * 8 + wid; \
        LAS float* scr_ = (LAS float*)(lds + wid * 16384); int ln_ = threadIdx.x & 63; asm volatile("" : "+v"(ln_)); \
        for (int it_ = (i0) + w_; it_ < (i1); it_ += nw_) convert_weights_item(ap, (l + 1) * IT_LAYER + it_, scr_, ln_); } } } while (0)
#define TAIL_CONVERT(nunits, i0, i1) TAIL_CONVERT_FROM((nunits) % Gp, i0, i1)
constexpr int CV0 = 0, CV1 = (IT_LAYER * 35) / 100, CV2 = (IT_LAYER * 42) / 100, CV3 = (IT_LAYER * 49) / 100, CV4 = (IT_LAYER * 83) / 100, CV5 = IT_LAYER;
__global__ void __launch_bounds__(512, 2) mk_fwd(Args Aarg) {
    extern __shared__ __attribute__((aligned(16))) unsigned char lds_raw[];
    LAS unsigned char* lds = (LAS unsigned char*)lds_raw;
    const int tid = threadIdx.x, lane = tid & 63, wid = __builtin_amdgcn_readfirstlane(tid >> 6);
    const int G = gridDim.x, bx = blockIdx.x;
    volatile LAS unsigned* MISC = (volatile LAS unsigned*)(lds + LDSCTL_OFF);
    for (int u = tid; u < 256; u += 512) ((LAS unsigned*)(lds + LDSCTL_OFF))[u] = 0u;
    __syncthreads();
    XcdBarrier bar; bar.bar = nullptr; bar.x = 0; bar.st = nullptr;
    if (MK_N_LAUNCHES == 1) bar = xcd_barrier_post((unsigned*)(Aarg.ws + WS_CTL) + CW_BAR, MISC + 8);
    const int lo = Aarg.ph_lo, hi = Aarg.ph_hi;
#ifndef PHMASK
#define PHMASK 0xFFFFFFFFu
#endif
#define IN(k) (lo <= (k) && (k) < hi)
#define PHON(b) ((PHMASK >> (b)) & 1u)
#ifndef PROBE_DUP
#define PROBE_DUP 0u
#endif
#define NREP(b) (1 + (int)((PROBE_DUP >> (b)) & 1u))
#define SEAM(k) do { if (MK_N_LAUNCHES == 1 && (k) + 1 < hi) xcd_barrier(bar); } while (0)
    const int gw = bx * 8 + wid, NGW = G * 8;

    if (PHON(0) && IN(0)) {
_Pragma("unroll") for (int rep_ = 0; rep_ < NREP(0); ++rep_) {
        PH_ENTER();
        for (int u = bx; u < DEPTH * 48; u += G) ada_unit(ap, u, lds, tid);
        for (int i = bx * 512 + tid; i < SEQ * 96; i += G * 512) {
            const int t = i / 96, e = i % 96;
            if (e < 64) { const int ax = e >> 5, f = e & 31; const float pos = ax ? (float)(t & 63) : (float)(t >> 6); const float ang = pos * powf(10000.0f, -(float)f / 32.0f);
                WSP(f32x2, WS_T128)[(size_t)t * 64 + e] = (f32x2){cosf(ang), sinf(ang)}; }
            else { const int e2 = e - 64, ax = e2 >> 4, f = e2 & 15; const float pos = ax ? (float)(t & 63) : (float)(t >> 6); const float ang = pos * powf(10000.0f, -(float)f / 16.0f);
                WSP(f32x2, WS_T64)[(size_t)t * 32 + e2] = (f32x2){cosf(ang), sinf(ang)}; }
        }
        if (bx == 0 && wid < DEPTH) { const float* cl = ap->in[I_CLAM] + wid * 256; const float s1 = wave_sum(cl[lane] * cl[64 + lane]), s2 = wave_sum(cl[128 + lane] * cl[192 + lane]);
            if (lane == 0) WSP(float, WS_LAM)[wid] = expf(s1) - expf(s2) + (0.8f - 0.6f * expf(-0.3f * (float)wid)); }
        { LAS float* scr = (LAS float*)(lds + wid * 16384);
          for (int it = gw; it < IT_LAYER; it += NGW) convert_weights_item(ap, it, scr, lane); }
        __syncthreads();
        }
            SEAM(0);
    }
    if (PHON(1) && IN(1)) {
        PH_ENTER(); const float* xin = ap->in[I_X]; const float* cin = ap->in[I_CTX];
        for (int row = gw; row < MT; row += NGW) {
            const float* src = row < ML ? xin + (size_t)row * DM : cin + (size_t)(row - ML) * DM;
            const float* ad = WSP(float, WS_ADA) + (size_t)(row < ML ? (row >> 11) : 4) * (6 * DM);
            ln_row(src, WSP(float, WS_X) + (size_t)row * DM, WSP(bf16_t, WS_HB) + (size_t)row * DM, nullptr, nullptr, ad + 1 * DM, ad + 0 * DM, lane);
        }
        SEAM(1);
    }
    for (int l = 0; l < DEPTH; ++l) {
        const int p0 = NPH_PRO + l * NPH_LAYER;
        if (hi <= p0 || lo >= p0 + NPH_LAYER) continue;
        const bool lastl = (l == DEPTH - 1);
        const int nMpost = lastl ? 32 : 36;
        if (PHON(2) && IN(p0 + 0)) {
_Pragma("unroll") for (int rep_ = 0; rep_ < NREP(2); ++rep_) {
            PH_ENTER();
            pg8::Gemm g{WSP(bf16_t, WS_HB), WSP(const bf16_t, WS_W + (size_t)l * WL_SIZE + WL_IN), DM, DM, DM}; pg8::Order<4> S; S.init(lastl ? 32 : 36, NIN / 256, Gp, bxp, DM, DM, DM, lastl ? 44 : 0);
            pg8::EpiIn E{WSP(bf16_t, WS_ACT), WSP(bf16_t, WS_G), WSP(bf16_t, WS_DQKV), WSP(float, WS_SSQ), WSP(const f32x4, WS_T128), WSP(const f32x4, WS_T64), ap->in[I_AQKN] + l * 256, (LAS float*)(lds + XCH_OFF)};
            pg8::gemm_phase(lds, g, S, E);
            TAIL_CONVERT(36 * (NIN / 256), CV0, CV1);
            }
            SEAM(p0 + 0);
        }
        if (PHON(3) && IN(p0 + 1)) {
_Pragma("unroll") for (int rep_ = 0; rep_ < NREP(3); ++rep_) {
            PH_ENTER();
            pg8::Gemm g{WSP(bf16_t, WS_DQKV), WSP(const bf16_t, WS_W + (size_t)l * WL_SIZE + WL_UP), 512, 512, 512}; pg8::Order<2> S; S.init(36, 7, Gp, bxp, 512, 512, 512);
            pg8::EpiUp E{WSP(bf16_t, WS_ACT), WSP(float, WS_SSQ), WSP(const f32x4, WS_T64)};
            pg8::gemm_phase(lds, g, S, E);
            }
            SEAM(p0 + 1);
        }
        if (PHON(4) && IN(p0 + 2)) {
_Pragma("unroll") for (int rep_ = 0; rep_ < NREP(4); ++rep_) {
            PH_ENTER();
            unsigned* qhead = WSP(unsigned, WS_CTL) + CW_QUEUE + 64 * l + 32 * rep_;
            bf16_t* ACT = WSP(bf16_t, WS_ACT); bf16_t* OUTS = WSP(bf16_t, WS_OUTS);
            const float lam = WSP(float, WS_LAM)[l], omli = 1.0f - (0.8f - 0.6f * expf(-0.3f * (float)l));
#define ATT_FETCH() do { if (tid == 0) MISC[16] = __hip_atomic_fetch_add(qhead, 1u, __ATOMIC_RELAXED, __HIP_MEMORY_SCOPE_AGENT); __syncthreads(); L = (int)MISC[16]; __syncthreads(); } while (0)
#define ATT_DECODE(base) const int r_ = L - (base); const bool isctx = r_ >= 128; const int b = isctx ? ((r_ - 128) >> 2) : (r_ >> 5), h = isctx ? (r_ & 3) : ((r_ >> 3) & 3), qb = isctx ? 0 : (r_ & 7); \
                const int qrow0 = isctx ? (ML + b * CTXL) : (b * SEQ + qb * 256); att::UnitArgs ua; ua.crow0 = ML + b * CTXL; ua.ntc = 4; ua.lrow0 = b * SEQ; ua.nt = isctx ? 4 : 36; ua.dpos = 0; ua.sink = 0.f; \
                ua.ldo = DM; ua.scr = WSP(float, WS_O1) + (size_t)qrow0 * 512 + h * 128; ua.lam = lam; ua.omli = omli; ua.gsub = ap->in[I_CSUBLN] + l * 128; ua.ldq = LDACT; ua.ldk = LDACT; ua.ldv = LDACT;
            int L; ATT_FETCH();
#ifndef ATTMASK
#define ATTMASK 15
#endif
            while ((ATTMASK & 1) && L < 144) {
                if (!(lastl && L >= 128)) { ATT_DECODE(0)
                    ua.Vb = ACT + C_CV + h * 128; ua.out = OUTS + (size_t)qrow0 * DM + 1024 + h * 128;
                    ua.Qb = ACT + (size_t)qrow0 * LDACT + C_CQ + h * 128; ua.Kb = ACT + C_CK + h * 128;
                    att::attn_unit<64, false, false, 1>(ua, (char*)lds_raw);
                    ua.Qb += 64; ua.Kb += 64;
                    att::attn_unit<64, false, false, 2>(ua, (char*)lds_raw); }
                ATT_FETCH();
            }
            while ((ATTMASK & 2) && L < 288) {
                if (!(lastl && L >= 272)) { ATT_DECODE(144)
                    ua.Qb = ACT + (size_t)qrow0 * LDACT + C_DQ + h * 192; ua.Kb = ACT + C_DK + h * 192; ua.Vb = ACT + C_DV + h * 128; ua.out = OUTS + (size_t)qrow0 * DM + 1536 + h * 128;
                    att::attn_unit<192, false, false, 0>(ua, (char*)lds_raw); }
                ATT_FETCH();
            }
            while ((ATTMASK & 4) && L < 432) {
                if (!(lastl && L >= 416)) { ATT_DECODE(288)
                    ua.Qb = ACT + (size_t)qrow0 * LDACT + C_AQ + h * 128; ua.Kb = ACT + C_AK + (h >> 1) * 128; ua.Vb = ACT + C_AV + (h >> 1) * 128; ua.out = OUTS + (size_t)qrow0 * DM + 0 + h * 128;
                    att::attn_unit<128, false, false, 0>(ua, (char*)lds_raw); }
                ATT_FETCH();
            }
            while ((ATTMASK & 8) && L < 576) {
                if (!(lastl && L >= 560)) { ATT_DECODE(432)
                    ua.Qb = ACT + (size_t)qrow0 * LDACT + C_BQ + h * 128; ua.Kb = ACT + C_BK + (h >> 1) * 128; ua.Vb = ACT + C_BV + (h >> 1) * 128; ua.out = OUTS + (size_t)qrow0 * DM + 512 + h * 128;
                    ua.sink = ap->in[I_BSINK][l * 4 + h];
                    if (!isctx) { const int t0 = (4 * qb - 2) < 0 ? 0 : (4 * qb - 2), t1 = (4 * qb + 5) > 31 ? 31 : (4 * qb + 5);
                        ua.lrow0 = b * SEQ + 64 * t0; ua.nt = 4 + (t1 - t0 + 1); ua.dpos = 64 * t0 - 256 * qb; }
                    att::attn_unit<128, true, true, 0>(ua, (char*)lds_raw); }
                ATT_FETCH();
            }
#undef ATT_FETCH
#undef ATT_DECODE
            }
            SEAM(p0 + 2);
        }
        if (PHON(5) && IN(p0 + 3)) {
            PH_ENTER();
            pg8::Gemm g{WSP(bf16_t, WS_OUTS), WSP(const bf16_t, WS_W + (size_t)l * WL_SIZE + WL_BR), 512, DM, 512}; pg8::Order<1> S; S.init(nMpost, 32, Gp, bxp, DM, 512, 512);
            pg8::EpiMerge E{WSP(bf16_t, WS_G)};
            pg8::gemm_phase(lds, g, S, E);
            TAIL_CONVERT(nMpost * 32, CV1, CV2);
            SEAM(p0 + 3);
        }
        if (PHON(6) && IN(p0 + 4)) {
_Pragma("unroll") for (int rep_ = 0; rep_ < NREP(6); ++rep_) {
            PH_ENTER(); const bf16_t* GT = WSP(bf16_t, WS_G); bf16_t* Y = WSP(bf16_t, WS_Y);
            const int nchunk = nMpost * 256 * (DM / 8); int t_ = threadIdx.x; asm volatile("" : "+v"(t_));
            for (int i = bx * 512 + t_; i < nchunk; i += G * 512) { const int row = i >> 8, c8 = (i & 255) * 8; const bf16_t* zp = GT + (size_t)row * 8192 + c8;
                const u32x4 z0 = *(const u32x4*)zp, z1 = *(const u32x4*)(zp + 2048), z2 = *(const u32x4*)(zp + 4096), z3 = *(const u32x4*)(zp + 6144); u32x4 w;
#define S4(f) ((bf_lo(z0.f) + bf_lo(z1.f)) + (bf_lo(z2.f) + bf_lo(z3.f))), ((bf_hi(z0.f) + bf_hi(z1.f)) + (bf_hi(z2.f) + bf_hi(z3.f)))
                w.x = cvt_pk_bf16(S4(x)); w.y = cvt_pk_bf16(S4(y)); w.z = cvt_pk_bf16(S4(z)); w.w = cvt_pk_bf16(S4(w));
#undef S4
                *(u32x4*)(Y + (size_t)row * DM + c8) = w; }
            }
            SEAM(p0 + 4);
        }
        if (PHON(7) && IN(p0 + 5)) {
_Pragma("unroll") for (int rep_ = 0; rep_ < NREP(7); ++rep_) {
            PH_ENTER();
            pg8::Gemm g{WSP(bf16_t, WS_Y), WSP(const bf16_t, WS_W + (size_t)l * WL_SIZE + WL_OUT), DM, DM, DM}; pg8::Order<3> S; S.init(32, 8, Gp, bxp, DM, DM, DM, lastl ? 0 : 128);
            pg8::EpiRes E{WSP(float, WS_X), WSP(float, WS_PRE), WSP(float, WS_ADA) + (size_t)l * 5 * (6 * DM) + 2 * DM, WSP(float, WS_PART)};
            pg8::gemm_phase(lds, g, S, E);
            TAIL_CONVERT_FROM(128, CV2, CV3);
            }
            SEAM(p0 + 5);
        }
        if (PHON(8) && IN(p0 + 6)) {
_Pragma("unroll") for (int rep_ = 0; rep_ < NREP(8); ++rep_) {
            PH_ENTER(); const float* gam = ap->in[I_LMG] + l * DM; const float* bet = ap->in[I_LMB] + l * DM;
            for (int row = gw; row < nMpost * 256; row += NGW) { const float* ad = WSP(float, WS_ADA) + (size_t)l * 5 * (6 * DM) + (size_t)(row < ML ? (row >> 11) : 4) * (6 * DM);
                const bool cx = row >= ML; ln_row((cx ? WSP(float, WS_PART) - (size_t)ML * DM : WSP(float, WS_PRE)) + (size_t)row * DM, WSP(float, WS_X) + (size_t)row * DM, WSP(bf16_t, WS_HB) + (size_t)row * DM, gam, bet, ad + 4 * DM, ad + 3 * DM, lane, cx ? (size_t)MC * DM : 0); }
            }
            SEAM(p0 + 6);
        }
        if (PHON(9) && IN(p0 + 7)) {
_Pragma("unroll") for (int rep_ = 0; rep_ < NREP(9); ++rep_) {
            PH_ENTER();
            pg8::Gemm g{WSP(bf16_t, WS_HB), WSP(const bf16_t, WS_W + (size_t)l * WL_SIZE + WL_FI), DM, DM, DM}; pg8::Order<0> S; S.init(nMpost, 2 * FF / 256, Gp, bxp, DM, DM, DM);
            pg8::EpiSwi E{WSP(bf16_t, WS_FH)};
            pg8::gemm_phase(lds, g, S, E);
            TAIL_CONVERT(nMpost * (2 * FF / 256), CV3, CV4);
            }
            SEAM(p0 + 7);
        }
        if (PHON(10) && IN(p0 + 8)) {
_Pragma("unroll") for (int rep_ = 0; rep_ < NREP(10); ++rep_) {
            PH_ENTER();
            pg8::Gemm g{WSP(bf16_t, WS_FH), WSP(const bf16_t, WS_W + (size_t)l * WL_SIZE + WL_FO), FF, FF, FF}; pg8::Order<3> S; S.init(32, 8, Gp, bxp, FF, FF, FF, lastl ? 0 : 128);
            pg8::EpiRes E{WSP(float, WS_X), WSP(float, WS_PRE), WSP(float, WS_ADA) + (size_t)l * 5 * (6 * DM) + 5 * DM, WSP(float, WS_PART)};
            pg8::gemm_phase(lds, g, S, E);
            TAIL_CONVERT_FROM(128, CV4, CV5);
            }
            SEAM(p0 + 8);
        }
        if (PHON(11) && IN(p0 + 9)) {
_Pragma("unroll") for (int rep_ = 0; rep_ < NREP(11); ++rep_) {
            PH_ENTER(); const float* gam = ap->in[I_LFG] + l * DM; const float* bet = ap->in[I_LFB] + l * DM;
            float* xo = lastl ? ap->out : WSP(float, WS_X);
            const float* adaN = WSP(float, WS_ADA) + (size_t)(lastl ? l : l + 1) * 5 * (6 * DM);
            for (int row = gw; row < nMpost * 256; row += NGW) { const float* ad = adaN + (size_t)(row < ML ? (row >> 11) : 4) * (6 * DM);
                const bool cx = row >= ML; ln_row((cx ? WSP(float, WS_PART) - (size_t)ML * DM : WSP(float, WS_PRE)) + (size_t)row * DM, xo + (size_t)row * DM, lastl ? nullptr : WSP(bf16_t, WS_HB) + (size_t)row * DM, gam, bet, ad + 1 * DM, ad + 0 * DM, lane, cx ? (size_t)MC * DM : 0); }
            }
            SEAM(p0 + 9);
        }
    }
#undef IN
#undef SEAM
}


#ifndef MK_DIAG
#define MK_DIAG 0
#endif
#if MK_DIAG
struct Reg { size_t off, bytes; };
__global__ void k_cksum(const unsigned char* ws, size_t off, size_t bytes, unsigned long long* slot) {
    const uint4* p = (const uint4*)(ws + off); const size_t n = bytes / 16; unsigned long long s = 0;
    for (size_t i = (size_t)blockIdx.x * blockDim.x + threadIdx.x; i < n; i += (size_t)gridDim.x * blockDim.x) { const uint4 v = p[i]; s += (unsigned long long)v.x * 3u + (unsigned long long)v.y * 5u + (unsigned long long)v.z * 7u + (unsigned long long)v.w * 11u + (i & 0xffff); }
    for (int o = 32; o >= 1; o >>= 1) s += __shfl_xor(s, o);
    if ((threadIdx.x & 63) == 0) atomicAdd(slot, s);
}
__global__ void k_diag_out(const unsigned long long* tab, int nph, float* out, int n) {
    int code = 0; for (int p = nph - 1; p >= 0; --p) if (tab[p] != tab[64 + p]) code = p + 1;
    for (int i = blockIdx.x * blockDim.x + threadIdx.x; i < n; i += gridDim.x * blockDim.x) out[i] = (i == 0) ? 1.0e6f * (float)code : 0.0f;
}
#endif
extern "C" void kernel_launch(void* const* d_in, const int* in_sizes, int n_in, void* d_out, int out_size, void* d_ws, size_t ws_size, hipStream_t stream) {
    static int grid = 0;
    if (grid == 0) {
        if (n_in != 23 || out_size != ML * DM || ws_size < WS_END) { fprintf(stderr, "kernel_launch: shape mismatch (n_in %d out %d ws %zu need %zu)\n", n_in, out_size, ws_size, (size_t)WS_END); grid = -1; return; }
        int dev = 0, cus = 0, per_cu = 0;
        if (hipGetDevice(&dev) != hipSuccess || hipDeviceGetAttribute(&cus, hipDeviceAttributeMultiprocessorCount, dev) != hipSuccess) { grid = -1; return; }
        if (hipFuncSetAttribute((const void*)mk_fwd, hipFuncAttributeMaxDynamicSharedMemorySize, LDS_BYTES) != hipSuccess) { fprintf(stderr, "kernel_launch: hipFuncSetAttribute failed\n"); grid = -1; return; }
        if (hipOccupancyMaxActiveBlocksPerMultiprocessor(&per_cu, (const void*)mk_fwd, 512, LDS_BYTES) != hipSuccess || per_cu < 1) { fprintf(stderr, "kernel_launch: occupancy query says %d\n", per_cu); }
        (void)hipGetLastError();
        grid = cus;
    }
    if (grid < 0) return;
    if (hipMemsetAsync((char*)d_ws + WS_CTL, 0, CTL_ZERO_BYTES, stream) != hipSuccess) return;
    Args a{};
    for (int i = 0; i < 23; ++i) a.in[i] = (const float*)d_in[i];
    a.out = (float*)d_out; a.ws = (unsigned char*)d_ws;
#if MK_DIAG
    {   unsigned long long* tab = (unsigned long long*)((char*)d_ws + WS_CTL + 512 * 1024);
        const int NP = DIAG_NP;
        for (int run = 0; run < 2; ++run) for (int p = 0; p < NP; ++p) {
            if (run == 1 && p == 0) hipMemsetAsync((char*)d_ws + WS_CTL, 0, 256 * 1024, stream);
            a.ph_lo = p; a.ph_hi = p + 1; hipLaunchKernelGGL(mk_fwd, dim3(grid), dim3(512), LDS_BYTES, stream, a);
            Reg regs[4]; int nr = 0; const int q = (p - 2) % 10;
            if (p == 0) { regs[nr++] = {WS_ADA, (size_t)DEPTH * 5 * 6 * DM * 4}; regs[nr++] = {WS_T128, 3 * MiB / 2}; regs[nr++] = {WS_LAM, 16}; regs[nr++] = {WS_W, DEPTH * WL_SIZE}; }
            else if (p == 1 || q == 6 || q == 9) { regs[nr++] = {WS_X, SZ_F32ROWS}; regs[nr++] = {WS_HB, SZ_BF16ROWS}; }
            else if (q == 0) { regs[nr++] = {WS_G, (size_t)MT * 8192 * 2}; regs[nr++] = {WS_DQKV, (size_t)2 * MT * 512 * 2}; regs[nr++] = {WS_SSQ, (size_t)MT * 16 * 4}; }
            else if (q == 1) { regs[nr++] = {WS_ACT, (size_t)MT * LDACT * 2}; }
            else if (q == 2) { regs[nr++] = {WS_OUTS, SZ_BF16ROWS}; regs[nr++] = {WS_O1, (size_t)MT * 512 * 4}; }
            else if (q == 3) { regs[nr++] = {WS_G, (size_t)MT * 8192 * 2}; }
            else if (q == 4) { regs[nr++] = {WS_Y, SZ_BF16ROWS}; }
            else if (q == 5 || q == 8) { regs[nr++] = {WS_PRE, SZ_F32ROWS}; }
            else if (q == 7) { regs[nr++] = {WS_FH, (size_t)MT * FF * 2}; }
            for (int r = 0; r < nr; ++r) hipLaunchKernelGGL(k_cksum, dim3(1024), dim3(256), 0, stream, (const unsigned char*)d_ws, regs[r].off, regs[r].bytes, tab + run * 64 + p);
        }
        hipLaunchKernelGGL(k_diag_out, dim3(1024), dim3(256), 0, stream, (const unsigned long long*)tab, NP, (float*)d_out, out_size);
        return;
    }
#endif
    if (MK_N_LAUNCHES == 1) { a.ph_lo = 0; a.ph_hi = NPH_TOTAL; hipLaunchKernelGGL(mk_fwd, dim3(grid), dim3(512), LDS_BYTES, stream, a); }
    else for (int p = 0; p < NPH_TOTAL; ++p) { a.ph_lo = p; a.ph_hi = p + 1; hipLaunchKernelGGL(mk_fwd, dim3(grid), dim3(512), LDS_BYTES, stream, a); }
    const hipError_t le = hipPeekAtLastError();
    if (le != hipSuccess) fprintf(stderr, "kernel_launch: launch failed: %s\n", hipGetErrorName(le));
}
```
